# Optimizing an MI355X kernel written in HIP

```python
import jax, jax.numpy as jnp
from jax import lax
import numpy as np

D_MODEL = 1024
BATCH = 32
SEQ = 2048
DEPTH = 4
DEC_BATCH = 32
DEC_SEQ = 16
PAST_LEN = 4096

CHUNK = 64
MIX_WIDTH = D_MODEL
POOL_WIDTH = MIX_WIDTH // 2
POOL_WINDOWS = (2, 4, 8, 16)
N_POOL_GROUPS = len(POOL_WINDOWS)
POOL_GROUP = POOL_WIDTH // N_POOL_GROUPS
POOL_HIST = max(POOL_WINDOWS) - 1
HEAD_DIM = 64
ATTN_WIDTH = MIX_WIDTH - POOL_WIDTH
N_Q_HEADS = ATTN_WIDTH // HEAD_DIM
N_KV_HEADS = 2
GQA_GROUP = N_Q_HEADS // N_KV_HEADS
KV_WIDTH = N_KV_HEADS * HEAD_DIM
WINDOW = 128
WIN_CHUNKS = WINDOW // CHUNK
IN_WIDTH = POOL_WIDTH + ATTN_WIDTH + 2 * KV_WIDTH
D_FF = -(-8 * D_MODEL // (3 * 256)) * 256
EPS = 1e-6

kernel_name = "hymba_pool_swa_sink_stream_step"


def rmsnorm(x, g):
    xf = x.astype(jnp.float32)
    y = xf * lax.rsqrt(jnp.mean(xf * xf, axis=-1, keepdims=True) + EPS)
    return (y * g.astype(jnp.float32)).astype(x.dtype)


def multiscale_pool(u, hist, pos0, w_lin, scale):
    B, T, P = u.shape
    z = jnp.concatenate([hist, u], axis=1).astype(jnp.float32)
    cs = jnp.concatenate([jnp.zeros((B, 1, P), jnp.float32), jnp.cumsum(z, axis=1)], axis=1)
    pos = pos0 + jnp.arange(T)
    means = []
    for g, w in enumerate(POOL_WINDOWS):
        sl = slice(g * POOL_GROUP, (g + 1) * POOL_GROUP)
        end = cs[:, POOL_HIST + 1:POOL_HIST + 1 + T, sl]
        start = cs[:, POOL_HIST + 1 - w:POOL_HIST + 1 - w + T, sl]
        cnt = jnp.minimum(pos + 1, w).astype(jnp.float32)[None, :, None]
        means.append((end - start) / cnt)
    d = (jnp.concatenate(means, axis=-1) - u.astype(jnp.float32)).astype(u.dtype)
    d = d.reshape(B, T, N_POOL_GROUPS, POOL_GROUP)
    y = jnp.einsum("btgc,gcd->btgd", d, w_lin).reshape(B, T, P)
    return y * scale


def sink_attention(q, k, v, mask, sinks):
    s = jnp.einsum("...qhgd,...khd->...hgqk", q, k).astype(jnp.float32) * (HEAD_DIM ** -0.5)
    s = jnp.where(mask, s, -jnp.inf)
    sink = sinks.astype(jnp.float32)[:, :, None, None]
    m = jnp.maximum(jnp.max(s, axis=-1, keepdims=True), sink)
    p = jnp.exp(s - m)
    denom = jnp.sum(p, axis=-1, keepdims=True) + jnp.exp(sink - m)
    return jnp.einsum("...hgqk,...khd->...qhgd", (p / denom).astype(v.dtype), v)


def banded_window_attention(q, k, v, sinks):
    B, T = q.shape[:2]
    NC = T // CHUNK
    qb = q.reshape(B, NC, CHUNK, N_KV_HEADS, GQA_GROUP, HEAD_DIM)
    pad = ((0, 0), (WIN_CHUNKS * CHUNK, 0), (0, 0), (0, 0))
    kp = jnp.pad(k, pad).reshape(B, NC + WIN_CHUNKS, CHUNK, N_KV_HEADS, HEAD_DIM)
    vp = jnp.pad(v, pad).reshape(B, NC + WIN_CHUNKS, CHUNK, N_KV_HEADS, HEAD_DIM)
    kb = jnp.concatenate([kp[:, j:j + NC] for j in range(WIN_CHUNKS + 1)], axis=2)
    vb = jnp.concatenate([vp[:, j:j + NC] for j in range(WIN_CHUNKS + 1)], axis=2)
    kb_len = (WIN_CHUNKS + 1) * CHUNK
    key_chunk = jnp.arange(NC)[:, None] - WIN_CHUNKS + jnp.arange(kb_len)[None, :] // CHUNK
    mask = (key_chunk >= 0)[None, :, None, None, None, :]
    o = sink_attention(qb, kb, vb, mask, sinks)
    return o.reshape(B, T, ATTN_WIDTH)


def cached_window_attention(q, k_all, v_all, pos0, sinks):
    B, T = q.shape[:2]
    qpos = pos0 + jnp.arange(T)
    kpos = pos0 - WINDOW + jnp.arange(WINDOW + T)
    qc = (qpos // CHUNK)[:, None]
    kc = (kpos // CHUNK)[None, :]
    mask = (kc <= qc) & (kc >= qc - WIN_CHUNKS) & (kpos[None, :] >= 0)
    qg = q.reshape(B, T, N_KV_HEADS, GQA_GROUP, HEAD_DIM)
    o = sink_attention(qg, k_all, v_all, mask, sinks)
    return o.reshape(B, T, ATTN_WIDTH)


def trunk_layer(x, c, hist_pool, hist_k, hist_v, pos0, w_ada, b_ada, g_mix, w_in, pool_w,
                pool_scale, sinks, w_out, g_ffn, w_gate_up, w_down):
    B, T, _ = x.shape
    mod = (jax.nn.silu(c) @ w_ada + b_ada)[:, None, :]
    sh1, sc1, ga1, sh2, sc2, ga2 = jnp.split(mod, 6, axis=-1)
    h = rmsnorm(x, g_mix) * (1 + sc1) + sh1
    proj = h @ w_in
    u, q, k, v = jnp.split(proj, [POOL_WIDTH, POOL_WIDTH + ATTN_WIDTH,
                                  POOL_WIDTH + ATTN_WIDTH + KV_WIDTH], axis=-1)
    q = q.reshape(B, T, N_Q_HEADS, HEAD_DIM)
    k = k.reshape(B, T, N_KV_HEADS, HEAD_DIM)
    v = v.reshape(B, T, N_KV_HEADS, HEAD_DIM)
    pool_out = multiscale_pool(u, hist_pool, pos0, pool_w, pool_scale)
    new_pool = jnp.concatenate([hist_pool, u], axis=1)[:, -POOL_HIST:]
    sk = sinks.reshape(N_KV_HEADS, GQA_GROUP)
    if hist_k is None:
        attn_out = banded_window_attention(q, k, v, sk)
        new_k, new_v = k[:, -WINDOW:], v[:, -WINDOW:]
    else:
        k_all = jnp.concatenate([hist_k, k], axis=1)
        v_all = jnp.concatenate([hist_v, v], axis=1)
        attn_out = cached_window_attention(q, k_all, v_all, pos0, sk)
        new_k, new_v = k_all[:, -WINDOW:], v_all[:, -WINDOW:]
    mix = jnp.concatenate([pool_out, attn_out], axis=-1) @ w_out
    x = x + ga1 * mix
    h = rmsnorm(x, g_ffn) * (1 + sc2) + sh2
    a, b = jnp.split(h @ w_gate_up, 2, axis=-1)
    x = x + ga2 * ((jax.nn.silu(a) * b) @ w_down)
    return x, new_pool, new_k, new_v


def setup_inputs(seed: int = 0) -> dict:
    key = jax.random.key(seed)
    ks = jax.random.split(key, 19)
    f32 = jnp.float32

    def nrm(k, shape, s):
        return jax.random.normal(k, shape, f32) * s

    return {
        "x_prompt": nrm(ks[0], (BATCH, SEQ, D_MODEL), 1.0),
        "x_sample": nrm(ks[1], (DEC_BATCH, DEC_SEQ, D_MODEL), 1.0),
        "cache_pool": nrm(ks[2], (DEPTH, DEC_BATCH, POOL_HIST, POOL_WIDTH), 1.0),
        "cache_k": nrm(ks[3], (DEPTH, DEC_BATCH, WINDOW, N_KV_HEADS, HEAD_DIM), 1.0),
        "cache_v": nrm(ks[4], (DEPTH, DEC_BATCH, WINDOW, N_KV_HEADS, HEAD_DIM), 1.0),
        "c_prompt": nrm(ks[5], (BATCH, D_MODEL), 1.0),
        "c_sample": nrm(ks[6], (DEC_BATCH, D_MODEL), 1.0),
        "w_ada": nrm(ks[7], (DEPTH, D_MODEL, 6 * D_MODEL), 0.5 * D_MODEL ** -0.5),
        "b_ada": nrm(ks[8], (DEPTH, 6 * D_MODEL), 0.02),
        "g_mix": 1.0 + nrm(ks[9], (DEPTH, D_MODEL), 0.02),
        "w_in": nrm(ks[10], (DEPTH, D_MODEL, IN_WIDTH), D_MODEL ** -0.5),
        "pool_w": nrm(ks[11], (DEPTH, N_POOL_GROUPS, POOL_GROUP, POOL_GROUP), POOL_GROUP ** -0.5),
        "pool_scale": 1.0 + nrm(ks[12], (DEPTH, POOL_WIDTH), 0.1),
        "sinks": nrm(ks[13], (DEPTH, N_Q_HEADS), 1.0),
        "w_out": nrm(ks[14], (DEPTH, MIX_WIDTH, D_MODEL), MIX_WIDTH ** -0.5),
        "g_ffn": 1.0 + nrm(ks[15], (DEPTH, D_MODEL), 0.02),
        "w_gate_up": nrm(ks[16], (DEPTH, D_MODEL, 2 * D_FF), D_MODEL ** -0.5),
        "w_down": nrm(ks[17], (DEPTH, D_FF, D_MODEL), D_FF ** -0.5),
        "g_final": 1.0 + nrm(ks[18], (D_MODEL,), 0.02),
    }


def reference(x_prompt, x_sample, cache_pool, cache_k, cache_v, c_prompt, c_sample, w_ada, b_ada,
              g_mix, w_in, pool_w, pool_scale, sinks, w_out, g_ffn, w_gate_up, w_down, g_final):
    xp, xs = x_prompt, x_sample
    zero_hist = jnp.zeros((xp.shape[0], POOL_HIST, POOL_WIDTH), xp.dtype)
    pool_p, k_p, v_p, pool_s, k_s, v_s = [], [], [], [], [], []
    for l in range(DEPTH):
        lw = (w_ada[l], b_ada[l], g_mix[l], w_in[l], pool_w[l], pool_scale[l], sinks[l],
              w_out[l], g_ffn[l], w_gate_up[l], w_down[l])
        xp, npool, nk, nv = trunk_layer(xp, c_prompt, zero_hist, None, None, 0, *lw)
        pool_p.append(npool); k_p.append(nk); v_p.append(nv)
        xs, npool, nk, nv = trunk_layer(xs, c_sample, cache_pool[l], cache_k[l], cache_v[l],
                                        PAST_LEN, *lw)
        pool_s.append(npool); k_s.append(nk); v_s.append(nv)
    y_prompt = rmsnorm(xp, g_final)
    y_sample = rmsnorm(xs, g_final)
    return (y_prompt, y_sample, jnp.stack(pool_p), jnp.stack(k_p), jnp.stack(v_p),
            jnp.stack(pool_s), jnp.stack(k_s), jnp.stack(v_s))
```

```cpp
#include <hip/hip_runtime.h>
#include <hip/hip_cooperative_groups.h>
#include <cstdio>
#include <cstdint>
namespace cg = cooperative_groups;

constexpr int DM = 1024, NBP = 32, SEQ = 2048, DEPTH = 4, NBS = 32, DSEQ = 16;
constexpr int MP = NBP * SEQ, MS = NBS * DSEQ, MT = MP + MS;
constexpr int PW = 512, AW = 512, KVW = 128, INW = 1280, DFF = 2816, NGU = 2 * DFF, NSEQ = 64, WIN = 128, PH = 15;
constexpr float EPS = 1e-6f;
constexpr float QSCALE = 0.125f * 1.4426950408889634f;
constexpr float LOG2E = 1.4426950408889634f;
constexpr size_t O_YP = 0, O_YS = (size_t)MP * DM, O_POOLP = O_YS + (size_t)MS * DM, SZ_POOL = (size_t)DEPTH * 32 * PH * PW, SZ_KV = (size_t)DEPTH * 32 * WIN * KVW;
constexpr size_t O_KP = O_POOLP + SZ_POOL, O_VP = O_KP + SZ_KV, O_POOLS = O_VP + SZ_KV, O_KS = O_POOLS + SZ_POOL, O_VS = O_KS + SZ_KV, O_END = O_VS + SZ_KV;
constexpr size_t WS_WIN = 0, WS_WO = WS_WIN + (size_t)DEPTH * INW * DM * 2, WS_WGU = WS_WO + (size_t)DEPTH * DM * DM * 2, WS_WD = WS_WGU + (size_t)DEPTH * NGU * DM * 2;
constexpr size_t WS_MOD = WS_WD + (size_t)DEPTH * DM * DFF * 2, WS_BIN = WS_MOD + (size_t)DEPTH * NSEQ * 6 * DM * 4, WS_BGU = WS_BIN + (size_t)DEPTH * NSEQ * INW * 4;
constexpr size_t WS_RSS = WS_BGU + (size_t)DEPTH * NSEQ * NGU * 4, WS_XN = WS_RSS + (size_t)MT * 16 * 4, WS_U = WS_XN + (size_t)MT * DM * 2;
constexpr size_t WS_Q = WS_U + (size_t)MT * PW * 2, WS_K = WS_Q + (size_t)MT * AW * 2, WS_V = WS_K + (size_t)MT * KVW * 2, WS_MIX = WS_V + (size_t)MT * KVW * 2;
constexpr size_t WS_H = WS_U  , WS_END = WS_H + (size_t)MT * DFF * 2;
static_assert(WS_MIX + (size_t)MT * DM * 2 <= WS_END, "H overlay covers U..MIX");
constexpr size_t WS_CTL = (WS_END + 4095) / 4096 * 4096, CTL_BYTES = 16384;
constexpr size_t WS_TOTAL = WS_CTL + CTL_BYTES;
constexpr int LDS_BYTES = 147456, XB_LDS_OFF = 131072 + 1024, EPI_LDS_OFF = 131072 + 2048, EGU_LDS_OFF = EPI_LDS_OFF + 6144;

namespace pg8 {
#define PG8_LAS __attribute__((address_space(3)))
typedef unsigned short bf16_t;
typedef short bf16x8 __attribute__((ext_vector_type(8)));
typedef float f32x4 __attribute__((ext_vector_type(4)));
typedef unsigned u32x4 __attribute__((ext_vector_type(4)));
constexpr int BM = 256, BK = 64, HALF = 128, HTB = HALF * BK * 2  , STAGE_BYTES = 8 * HTB, NXCD = 8, WGM = 4;

__host__ __device__ __forceinline__ int lds_byte(int r, int c) { const int st = (r >> 4) * 2 + (c >> 5), rr = r & 15, cc = c & 31, ob = rr * 64 + cc * 2; return st * 1024 + (ob ^ (((ob >> 9) & 1) << 5)); }
__host__ __device__ __forceinline__ void stage_rc(int b, int& R, int& C) { const int st = b / 1024, sb = b % 1024, swz = sb ^ (((sb >> 9) & 1) << 5); R = (st >> 1) * 16 + swz / 64; C = (st & 1) * 32 + (swz % 64) / 2; }
__host__ __device__ __forceinline__ int perm32(int rho) { const int n = rho >> 4, i = rho & 15; return 8 * (i >> 2) + 4 * n + (i & 3); }

struct Unit { int pm, pn; };
struct Gemm { const bf16_t* A; const bf16_t* Bt; int M, N, K; };

struct StaticOrder {
    int nM, nN, nwg, G, c, rev;
    __host__ __device__ void init(int M, int N, int G_, int c_, int rev_ = 0) { nM = M / BM; nN = N / BM; nwg = nM * nN; G = G_; c = c_; rev = rev_; }
    __host__ __device__ bool next(int i, Unit& u) const {
        const long L = (long)i * G + c; if (L >= nwg) return false;
        int wgid = (int)L; { const int q = nwg / NXCD, r = nwg % NXCD, xcd = wgid % NXCD, off = wgid / NXCD; wgid = (xcd < r ? xcd * (q + 1) : r * (q + 1) + (xcd - r) * q) + off; }
        const int nig = WGM * nN, gid = wgid / nig, fm = gid * WGM, gsz = (nM - fm) < WGM ? (nM - fm) : WGM;
        u.pm = fm + ((wgid % nig) % gsz); u.pn = (wgid % nig) / gsz; if (rev) u.pm = (u.pm & ~31) | (31 - (u.pm & 31)); return true;
    }
    __device__ __forceinline__ void a_ready(const Unit&) const {}
    __device__ __forceinline__ void done(const Unit&) const {}
};


typedef float f32x2_t __attribute__((ext_vector_type(2))); typedef __bf16 bf16x2_t __attribute__((ext_vector_type(2)));
__device__ __forceinline__ unsigned cvtpk(float lo, float hi) { f32x2_t v = {lo, hi}; bf16x2_t b = __builtin_convertvector(v, bf16x2_t); return __builtin_bit_cast(unsigned, b); }
__device__ __forceinline__ u32x4 pack8(f32x4 a, f32x4 b) { u32x4 w; w.x = cvtpk(a[0], a[1]); w.y = cvtpk(a[2], a[3]); w.z = cvtpk(b[0], b[1]); w.w = cvtpk(b[2], b[3]); return w; }
__device__ __forceinline__ int row_seq(int row) { return row < MP ? (row >> 11) : 32 + ((row - MP) >> 4); }
__device__ __forceinline__ void load_rstd(float (&rs)[2][4], const float* rss, const Unit& u, int wr, int fr, int fq) {
#pragma unroll
    for (int ai = 0; ai < 2; ++ai)
#pragma unroll
        for (int m = 0; m < 4; ++m) { const int row = u.pm * BM + ai * HALF + wr * 64 + m * 16 + fr; const f32x4 p = *(const f32x4*)(rss + (size_t)row * 16 + fq * 4);
            float s = (p[0] + p[1]) + (p[2] + p[3]); s += __shfl_xor(s, 16); s += __shfl_xor(s, 32); rs[ai][m] = rsqrtf(s * (1.0f / DM) + EPS); }
}

struct EpiIn {
    static constexpr bool PERM = true, AFTER_DRAIN = false, WANTS_NEXT = false;
    const float* rss; const float* bias;
    bf16_t *U, *Q, *K, *V;
    __device__ __forceinline__ void operator()(const f32x4 (&acc)[2][2][4][2], const Unit& u, int wr, int wc, int fr, int fq) const {
        const int ct = u.pn * BM, cl = wc * 32 + 8 * fq;
        bf16_t *d0, *d1; int pitch; float sc = 1.f;
        if (ct < 512) { d0 = U + ct + cl; d1 = d0 + HALF; pitch = PW; }
        else if (ct < 1024) { d0 = Q + (ct - 512) + cl; d1 = d0 + HALF; pitch = AW; sc = QSCALE; }
        else { d0 = K + cl; d1 = V + cl; pitch = KVW; }
        const float* bp = bias + (size_t)(u.pm >> 3) * INW + ct + cl;
        float rs[2][4]; load_rstd(rs, rss, u, wr, fr, fq);
        const f32x4 b0 = *(const f32x4*)bp * sc, b1 = *(const f32x4*)(bp + 4) * sc, b2 = *(const f32x4*)(bp + HALF) * sc, b3 = *(const f32x4*)(bp + HALF + 4) * sc;
#pragma unroll
        for (int ai = 0; ai < 2; ++ai)
#pragma unroll
            for (int m = 0; m < 4; ++m) {
                const size_t ro = (size_t)(u.pm * BM + ai * HALF + wr * 64 + m * 16 + fr) * pitch; const float r = rs[ai][m] * sc;
                *(u32x4*)(d0 + ro) = pack8(acc[ai][0][m][0] * r + b0, acc[ai][0][m][1] * r + b1);
                *(u32x4*)(d1 + ro) = pack8(acc[ai][1][m][0] * r + b2, acc[ai][1][m][1] * r + b3);
            }
    }
};

__device__ __forceinline__ void unpack8(u32x4 w, f32x4& lo, f32x4& hi) {
    lo = (f32x4){__uint_as_float(w.x << 16), __uint_as_float(w.x & 0xffff0000u), __uint_as_float(w.y << 16), __uint_as_float(w.y & 0xffff0000u)};
    hi = (f32x4){__uint_as_float(w.z << 16), __uint_as_float(w.z & 0xffff0000u), __uint_as_float(w.w << 16), __uint_as_float(w.w & 0xffff0000u)}; }
__device__ __forceinline__ f32x4 gm4(f32x4 g, f32x4 sc) { f32x4 v = g * (sc + 1.0f);
#pragma unroll
    for (int i = 0; i < 4; ++i) v[i] = __builtin_fabsf(v[i]) < 1e-6f ? __builtin_copysignf(1e-6f, v[i]) : v[i];
    return v; }
struct EpiRes {
    static constexpr bool PERM = true, AFTER_DRAIN = false, WANTS_NEXT = false;
    bf16_t* xn;
    const float* gate;
    const float* psc; const float* pg;
    const float* nsc; const float* ng;
    float* rss;
    PG8_LAS float* sv;
    __device__ __forceinline__ void operator()(const f32x4 (&acc)[2][2][4][2], const Unit& u, int wr, int wc, int fr, int fq) const {
        float ss[2][4];
#pragma unroll
        for (int ai = 0; ai < 2; ++ai)
#pragma unroll
            for (int m = 0; m < 4; ++m) ss[ai][m] = 0.f;
        const size_t so = (size_t)(u.pm >> 3) * (6 * DM);
        PG8_LAS float* sw = sv + (wr * 4 + wc) * 192 + fq * 8;
        {
            const int vb = fr >> 3, e = fr & 7, c = u.pn * BM + vb * HALF + wc * 32 + 8 * fq + e;
            float gp = pg[c] * (psc[so + c] + 1.0f); gp = __builtin_fabsf(gp) < 1e-6f ? __builtin_copysignf(1e-6f, gp) : gp;
            float gn = 1.0f; if (nsc) { gn = ng[c] * (nsc[so + c] + 1.0f); gn = __builtin_fabsf(gn) < 1e-6f ? __builtin_copysignf(1e-6f, gn) : gn; }
            sw[(vb * 3) * 32 + e] = gate[so + c]; sw[(vb * 3 + 1) * 32 + e] = 1.0f / gp; sw[(vb * 3 + 2) * 32 + e] = gn;
        }
#pragma unroll
        for (int bj = 0; bj < 2; ++bj) {
            const int c0 = u.pn * BM + bj * HALF + wc * 32 + 8 * fq;
            u32x4 xr[2][4];
#pragma unroll
            for (int ai = 0; ai < 2; ++ai)
#pragma unroll
                for (int m = 0; m < 4; ++m) xr[ai][m] = *(const u32x4*)(xn + (size_t)(u.pm * BM + ai * HALF + wr * 64 + m * 16 + fr) * DM + c0);
            asm volatile("s_waitcnt lgkmcnt(0)" ::: "memory");
#pragma unroll
            for (int ai = 0; ai < 2; ++ai)
#pragma unroll
                for (int m = 0; m < 4; ++m) {
                    const size_t ro = (size_t)(u.pm * BM + ai * HALF + wr * 64 + m * 16 + fr) * DM + c0;
                    f32x4 x0, x1; unpack8(xr[ai][m], x0, x1);
                    x0 = x0 * *(const PG8_LAS f32x4*)(sw + (bj * 3 + 1) * 32) + *(const PG8_LAS f32x4*)(sw + (bj * 3) * 32) * acc[ai][bj][m][0];
                    x1 = x1 * *(const PG8_LAS f32x4*)(sw + (bj * 3 + 1) * 32 + 4) + *(const PG8_LAS f32x4*)(sw + (bj * 3) * 32 + 4) * acc[ai][bj][m][1];
                    ss[ai][m] += ((x0[0] * x0[0] + x0[1] * x0[1]) + (x0[2] * x0[2] + x0[3] * x0[3])) + ((x1[0] * x1[0] + x1[1] * x1[1]) + (x1[2] * x1[2] + x1[3] * x1[3]));
                    *(u32x4*)(xn + ro) = pack8(x0 * *(const PG8_LAS f32x4*)(sw + (bj * 3 + 2) * 32), x1 * *(const PG8_LAS f32x4*)(sw + (bj * 3 + 2) * 32 + 4));
                    if (m == 3) asm volatile("" ::: "memory");
                }
        }
#pragma unroll
        for (int ai = 0; ai < 2; ++ai)
#pragma unroll
            for (int m = 0; m < 4; ++m) { float s = ss[ai][m]; s += __shfl_xor(s, 16); s += __shfl_xor(s, 32);
                if (fq == 0) rss[(size_t)(u.pm * BM + ai * HALF + wr * 64 + m * 16 + fr) * 16 + u.pn * 4 + wc] = s; }
    }
};

struct EpiGU {
    static constexpr bool PERM = true, AFTER_DRAIN = false, WANTS_NEXT = true;
    const float* rss; const float* bias;
    bf16_t* H;
    PG8_LAS float* st;
    __device__ __forceinline__ void fetch(const Unit& u, int wr, int wc, int fr, int fq, f32x4 (&pp)[2][4], f32x4 (&bb)[4]) const {
#pragma unroll
        for (int ai = 0; ai < 2; ++ai)
#pragma unroll
            for (int m = 0; m < 4; ++m) pp[ai][m] = *(const f32x4*)(rss + (size_t)(u.pm * BM + ai * HALF + wr * 64 + m * 16 + fr) * 16 + fq * 4);
        const float* bp = bias + (size_t)(u.pm >> 3) * NGU + u.pn * BM + wc * 32 + 8 * fq;
        bb[0] = *(const f32x4*)bp; bb[1] = *(const f32x4*)(bp + 4); bb[2] = *(const f32x4*)(bp + HALF); bb[3] = *(const f32x4*)(bp + HALF + 4);
    }
    __device__ __forceinline__ void park(int wr, int wc, int fr, int fq, const f32x4 (&pp)[2][4], const f32x4 (&bb)[4]) const {
        PG8_LAS float* sw = st + (wr * 4 + wc) * 192; float rs[2][4];
#pragma unroll
        for (int ai = 0; ai < 2; ++ai)
#pragma unroll
            for (int m = 0; m < 4; ++m) { const f32x4 p = pp[ai][m]; float s = (p[0] + p[1]) + (p[2] + p[3]); s += __shfl_xor(s, 16); s += __shfl_xor(s, 32); rs[ai][m] = rsqrtf(s * (1.0f / DM) + EPS); }
        if (fq == 0) { *(PG8_LAS f32x4*)(sw + fr * 8) = (f32x4){rs[0][0], rs[0][1], rs[0][2], rs[0][3]}; *(PG8_LAS f32x4*)(sw + fr * 8 + 4) = (f32x4){rs[1][0], rs[1][1], rs[1][2], rs[1][3]}; }
        if (fr == 0) {
#pragma unroll
            for (int q = 0; q < 4; ++q) *(PG8_LAS f32x4*)(sw + 128 + fq * 16 + 4 * q) = bb[q]; }
    }
    __device__ __forceinline__ void prime(const Unit& u, int wr, int wc, int fr, int fq) const { f32x4 pp[2][4], bb[4]; fetch(u, wr, wc, fr, fq, pp, bb); park(wr, wc, fr, fq, pp, bb); }
    __device__ __forceinline__ void operator()(const f32x4 (&acc)[2][2][4][2], const Unit& u, bool has_next, const Unit& nx, int wr, int wc, int fr, int fq) const {
        PG8_LAS float* sw = st + (wr * 4 + wc) * 192;
        const f32x4 r0 = *(const PG8_LAS f32x4*)(sw + fr * 8), r1 = *(const PG8_LAS f32x4*)(sw + fr * 8 + 4);
        const f32x4 ba0 = *(const PG8_LAS f32x4*)(sw + 128 + fq * 16), ba1 = *(const PG8_LAS f32x4*)(sw + 128 + fq * 16 + 4), bb0 = *(const PG8_LAS f32x4*)(sw + 128 + fq * 16 + 8), bb1 = *(const PG8_LAS f32x4*)(sw + 128 + fq * 16 + 12);
        f32x4 pp[2][4], nb[4];
        if (has_next) fetch(nx, wr, wc, fr, fq, pp, nb);
        const int hc = u.pn * HALF + wc * 32 + 8 * fq;
#pragma unroll
        for (int ai = 0; ai < 2; ++ai)
#pragma unroll
            for (int m = 0; m < 4; ++m) {
                const int row = u.pm * BM + ai * HALF + wr * 64 + m * 16 + fr; const float r = ai ? r1[m] : r0[m];
                const f32x4 a0 = acc[ai][0][m][0] * r + ba0, a1 = acc[ai][0][m][1] * r + ba1, b0 = acc[ai][1][m][0] * r + bb0, b1 = acc[ai][1][m][1] * r + bb1;
                f32x4 h0, h1;
#pragma unroll
                for (int i = 0; i < 4; ++i) { h0[i] = a0[i] * b0[i] * __builtin_amdgcn_rcpf(1.0f + __builtin_amdgcn_exp2f(-LOG2E * a0[i])); h1[i] = a1[i] * b1[i] * __builtin_amdgcn_rcpf(1.0f + __builtin_amdgcn_exp2f(-LOG2E * a1[i])); }
                *(u32x4*)(H + (size_t)row * DFF + hc) = pack8(h0, h1);
            }
        if (has_next) park(wr, wc, fr, fq, pp, nb);
    }
};

template <class Epi, class Sched, bool ALIGN_EPI = false, bool SP2 = false>
__device__ __forceinline__ void gemm_phase(PG8_LAS unsigned char* lds, const Gemm g, const Sched& S, const Epi& E, int tid_in) {
    int tid = tid_in; asm volatile("" : "+v"(tid));
    const int wid = __builtin_amdgcn_readfirstlane(tid >> 6), lane = tid & 63, wr = wid >> 2, wc = wid & 3, fr = lane & 15, fq = lane >> 4;
    const int K = g.K, nt = K / BK;
    unsigned voffA[2], voffB[2];
#pragma unroll
    for (int i = 0; i < 2; ++i) { int R, C; stage_rc(tid * 16 + i * 8192, R, C); const int Rb = Epi::PERM ? ((R & ~31) + perm32(R & 31)) : R;
        voffA[i] = (unsigned)(R * K + C) * 2u; voffB[i] = (unsigned)(Rb * K + C) * 2u; }
    const size_t kstep = (size_t)(BK * 2);
    const size_t hstep = (size_t)HALF * K * 2;
    const size_t tstep = 2 * hstep;
    const unsigned ldsw = (unsigned)wid * 1024u;
    const int aoff = lds_byte(wr * 64 + fr, fq * 8), boff = lds_byte(wc * 32 + fr, fq * 8);
#define PG8_SA(b, h) (((b) * 2 + (h)) * HTB)
#define PG8_SB(b, h) ((4 + (b) * 2 + (h)) * HTB)
#define PG8_STAGE(bufoff, gbase, voff) do { _Pragma("unroll") for (int _i = 0; _i < 2; ++_i) \
        __builtin_amdgcn_global_load_lds((const unsigned*)((const char*)(gbase) + (voff)[_i]), (PG8_LAS unsigned*)(lds + (bufoff) + ldsw + _i * 8192), 16, 0, 0); } while (0)
#define PG8_LDA(dst, b, h) do { _Pragma("unroll") for (int m = 0; m < 4; ++m) _Pragma("unroll") for (int k = 0; k < 2; ++k) dst[m][k] = *(const PG8_LAS bf16x8*)(lds + PG8_SA(b, h) + aoff + m * 2048 + k * 1024); } while (0)
#define PG8_LDB(dst, b, h) do { _Pragma("unroll") for (int n = 0; n < 2; ++n) _Pragma("unroll") for (int k = 0; k < 2; ++k) dst[n][k] = *(const PG8_LAS bf16x8*)(lds + PG8_SB(b, h) + boff + n * 2048 + k * 1024); } while (0)
#define PG8_MMA(ai, bj, At, Bt) do { __builtin_amdgcn_s_setprio(1); _Pragma("unroll") for (int m = 0; m < 4; ++m) _Pragma("unroll") for (int n = 0; n < 2; ++n) _Pragma("unroll") for (int k = 0; k < 2; ++k) \
        acc[ai][bj][m][n] = __builtin_amdgcn_mfma_f32_16x16x32_bf16(Bt[n][k], At[m][k], acc[ai][bj][m][n], 0, 0, 0); __builtin_amdgcn_s_setprio(0); } while (0)
#define PG8_WAIT_V(n) asm volatile("s_waitcnt vmcnt(" #n ")" ::: "memory")
#define PG8_WAIT_L(n) asm volatile("s_waitcnt lgkmcnt(" #n ")" ::: "memory")
#define PG8_BAR __builtin_amdgcn_s_barrier()
#define PG8_SCHED __builtin_amdgcn_sched_barrier(0)
    Unit cur, nxt; int ui = 0;
    if (!S.next(0, cur)) return;
    if constexpr (Epi::WANTS_NEXT) E.prime(cur, wr, wc, fr, fq);
    f32x4 acc[2][2][4][2];
#pragma unroll
    for (int a = 0; a < 2; ++a)
#pragma unroll
        for (int b = 0; b < 2; ++b)
#pragma unroll
            for (int m = 0; m < 4; ++m)
#pragma unroll
                for (int n = 0; n < 2; ++n) acc[a][b][m][n] = (f32x4){0.f, 0.f, 0.f, 0.f};
    bf16x8 At[4][2], B0[2][2], B1[2][2];
    const char* cA = (const char*)g.A + (size_t)cur.pm * tstep; const char* cB = (const char*)g.Bt + (size_t)cur.pn * tstep;
    S.a_ready(cur);
    if constexpr (SP2) {
        PG8_STAGE(PG8_SB(0, 0), cB, voffB); PG8_STAGE(PG8_SB(0, 1), cB + hstep, voffB); PG8_STAGE(PG8_SA(0, 0), cA, voffA); PG8_STAGE(PG8_SA(0, 1), cA + hstep, voffA);
        if (wr == 1) PG8_BAR;
        PG8_WAIT_V(2); PG8_BAR;
        PG8_STAGE(PG8_SB(1, 0), cB + kstep, voffB); PG8_STAGE(PG8_SA(1, 0), cA + kstep, voffA); PG8_STAGE(PG8_SB(1, 1), cB + hstep + kstep, voffB);
        PG8_WAIT_V(6); PG8_BAR;
    } else {
        PG8_STAGE(PG8_SB(0, 0), cB, voffB); PG8_STAGE(PG8_SA(0, 0), cA, voffA); PG8_STAGE(PG8_SB(0, 1), cB + hstep, voffB); PG8_STAGE(PG8_SA(0, 1), cA + hstep, voffA);
        if (wr == 1) PG8_BAR;
        PG8_WAIT_V(4); PG8_BAR;
        PG8_STAGE(PG8_SB(1, 0), cB + kstep, voffB); PG8_STAGE(PG8_SA(1, 0), cA + kstep, voffA); PG8_STAGE(PG8_SB(1, 1), cB + hstep + kstep, voffB);
        PG8_WAIT_V(6); PG8_BAR;
    }
    for (;;) {
        const bool has_next = S.next(ui + 1, nxt);
        const char* nA = has_next ? (const char*)g.A + (size_t)nxt.pm * tstep : cA; const char* nB = has_next ? (const char*)g.Bt + (size_t)nxt.pn * tstep : cB;
        for (int t = 0; t < nt; t += 2) {
            const bool last = (t == nt - 2);
            const char* a1 = cA + (size_t)(t + 1) * kstep;
            const char* a2 = last ? nA : cA + (size_t)(t + 2) * kstep; const char* b2 = last ? nB : cB + (size_t)(t + 2) * kstep;
            const char* a3 = a2 + kstep; const char* b3 = b2 + kstep;
            if (last && has_next) S.a_ready(nxt);
            if constexpr (SP2) {
            PG8_LDB(B0, 0, 0); PG8_LDB(B1, 0, 1); PG8_SCHED; PG8_LDA(At, 0, 0); PG8_STAGE(PG8_SA(1, 1), a1 + hstep, voffA);
            PG8_WAIT_V(8); PG8_WAIT_L(0); PG8_BAR; PG8_MMA(0, 0, At, B0); PG8_MMA(0, 1, At, B1); PG8_BAR; PG8_SCHED;
            PG8_LDA(At, 0, 1); PG8_STAGE(PG8_SB(0, 0), b2, voffB); PG8_STAGE(PG8_SB(0, 1), b2 + hstep, voffB); PG8_STAGE(PG8_SA(0, 0), a2, voffA);
            PG8_WAIT_V(8); PG8_WAIT_L(0); PG8_BAR; PG8_MMA(1, 0, At, B0); PG8_MMA(1, 1, At, B1); PG8_BAR; PG8_SCHED;
            PG8_LDB(B0, 1, 0); PG8_LDB(B1, 1, 1); PG8_SCHED; PG8_LDA(At, 1, 0); PG8_STAGE(PG8_SA(0, 1), a2 + hstep, voffA);
            PG8_WAIT_V(8); PG8_WAIT_L(0); PG8_BAR; PG8_MMA(0, 0, At, B0); PG8_MMA(0, 1, At, B1); PG8_BAR; PG8_SCHED;
            PG8_LDA(At, 1, 1); PG8_STAGE(PG8_SB(1, 0), b3, voffB); PG8_STAGE(PG8_SB(1, 1), b3 + hstep, voffB); PG8_STAGE(PG8_SA(1, 0), a3, voffA);
            PG8_WAIT_V(8); PG8_WAIT_L(0); PG8_BAR; PG8_MMA(1, 0, At, B0); PG8_MMA(1, 1, At, B1); PG8_BAR; PG8_SCHED;
            } else {
            PG8_LDB(B0, 0, 0); PG8_SCHED; PG8_LDA(At, 0, 0); PG8_STAGE(PG8_SA(1, 1), a1 + hstep, voffA);
            PG8_WAIT_L(8); PG8_BAR; PG8_WAIT_L(0); PG8_MMA(0, 0, At, B0); PG8_BAR; PG8_SCHED;
            PG8_LDB(B1, 0, 1); PG8_STAGE(PG8_SB(0, 0), b2, voffB);
            PG8_BAR; PG8_WAIT_L(0); PG8_MMA(0, 1, At, B1); PG8_BAR;
            PG8_LDA(At, 0, 1); PG8_STAGE(PG8_SA(0, 0), a2, voffA);
            PG8_BAR; PG8_WAIT_L(0); PG8_MMA(1, 0, At, B0); PG8_BAR; PG8_SCHED;
            PG8_STAGE(PG8_SB(0, 1), b2 + hstep, voffB);
            PG8_WAIT_V(6); PG8_BAR; PG8_MMA(1, 1, At, B1); PG8_BAR;
            PG8_LDB(B0, 1, 0); PG8_SCHED; PG8_LDA(At, 1, 0); PG8_STAGE(PG8_SA(0, 1), a2 + hstep, voffA);
            PG8_WAIT_L(8); PG8_BAR; PG8_WAIT_L(0); PG8_MMA(0, 0, At, B0); PG8_BAR; PG8_SCHED;
            PG8_LDB(B1, 1, 1); PG8_STAGE(PG8_SB(1, 0), b3, voffB);
            PG8_BAR; PG8_WAIT_L(0); PG8_MMA(0, 1, At, B1); PG8_BAR;
            PG8_LDA(At, 1, 1); PG8_STAGE(PG8_SA(1, 0), a3, voffA);
            PG8_BAR; PG8_WAIT_L(0); PG8_MMA(1, 0, At, B0); PG8_BAR; PG8_SCHED;
            PG8_STAGE(PG8_SB(1, 1), b3 + hstep, voffB);
            PG8_WAIT_V(6); PG8_BAR; PG8_MMA(1, 1, At, B1); PG8_BAR;
            }
        }
        if constexpr (ALIGN_EPI) { if (wr == 0) PG8_BAR; }
        if constexpr (!Epi::AFTER_DRAIN) { if constexpr (Epi::WANTS_NEXT) E(acc, cur, has_next, nxt, wr, wc, fr, fq); else E(acc, cur, wr, wc, fr, fq); S.done(cur); }
        if (!has_next) break;
#pragma unroll
        for (int a = 0; a < 2; ++a)
#pragma unroll
            for (int b = 0; b < 2; ++b)
#pragma unroll
                for (int m = 0; m < 4; ++m)
#pragma unroll
                    for (int n = 0; n < 2; ++n) acc[a][b][m][n] = (f32x4){0.f, 0.f, 0.f, 0.f};
        cur = nxt; cA = nA; cB = nB; ++ui;
        if constexpr (ALIGN_EPI) { if (wr == 1) PG8_BAR; }
    }
    PG8_WAIT_V(0);
    if constexpr (!ALIGN_EPI) { if (wr == 0) PG8_BAR; }
    PG8_BAR;
    if constexpr (Epi::AFTER_DRAIN) { E.fused(acc, cur, wr, wc, fr, fq, lds, wid, lane); S.done(cur); }
#undef PG8_SA
#undef PG8_SB
#undef PG8_STAGE
#undef PG8_LDA
#undef PG8_LDB
#undef PG8_MMA
#undef PG8_WAIT_V
#undef PG8_WAIT_L
#undef PG8_BAR
#undef PG8_SCHED
}
}

#define LAS __attribute__((address_space(3)))
#define XB_TMO      128
#define XB_XCNT(j)  (256  + 64 * (j))
#define XB_XSUB(j)  (1280 + 64 * (j))
#define XB_XGEN(j)  (2304 + 64 * (j))
#define XB_TOP      3328
#define XB_TOPGEN   3392
#define XCD_BAR_WORDS 3456
#define XB_SPIN_CAP (1u << 18)

__device__ __forceinline__ unsigned xb_ld(unsigned* p)              { return __hip_atomic_load(p, __ATOMIC_RELAXED, __HIP_MEMORY_SCOPE_AGENT); }
__device__ __forceinline__ unsigned xb_add(unsigned* p, unsigned v) { return __hip_atomic_fetch_add(p, v, __ATOMIC_RELAXED, __HIP_MEMORY_SCOPE_AGENT); }
__device__ __forceinline__ unsigned xb_xcc_id() { return (unsigned)__builtin_amdgcn_s_getreg((3 << 11) | 20) & 0xFu; }
#define XB_SPIN(cond, bar) do { unsigned _sp = 0; while (cond) { __builtin_amdgcn_s_sleep(1); \
    if ((++_sp & 255u) == 0u) { if (xb_ld(&(bar)[XB_TMO])) break; if (_sp > XB_SPIN_CAP) { atomicAdd(&(bar)[XB_TMO], 1u); break; } } } } while (0)

struct XcdBarrier {
    unsigned* bar; unsigned x;
    volatile LAS unsigned* st;
};

__device__ __forceinline__ XcdBarrier xcd_barrier_post(unsigned* bar, volatile LAS unsigned* st) {
    XcdBarrier b; b.bar = bar; b.x = xb_xcc_id(); b.st = st;
    if (threadIdx.x == 0) (void)xb_add(&bar[XB_XCNT(b.x)], 1u);
    return b;
}
__device__ __forceinline__ void xcd_barrier_complete(unsigned* bar, unsigned x, unsigned& nloc, unsigned& nx) {
    const unsigned G = gridDim.x * gridDim.y * gridDim.z;
    unsigned sum, cnt, mine, sp = 0u;
    for (;;) {
        sum = 0u; cnt = 0u; mine = 0u;
#pragma unroll
        for (unsigned j = 0; j < 16; ++j) { const unsigned c = xb_ld(&bar[XB_XCNT(j)]); sum += c; cnt += (c > 0u) ? 1u : 0u; mine = (j == x) ? c : mine; }
        if (sum == G) break;
        __builtin_amdgcn_s_sleep(1);
        if ((++sp & 255u) == 0u) { if (xb_ld(&bar[XB_TMO])) break; if (sp > XB_SPIN_CAP) { atomicAdd(&bar[XB_TMO], 1u); break; } }
    }
    nloc = mine > 0u ? mine : 1u; nx = cnt > 0u ? cnt : 1u;
}

__device__ __forceinline__ void xcd_barrier(const XcdBarrier& b) {
    asm volatile("s_waitcnt vmcnt(0)" ::: "memory");
    __syncthreads();
    if (threadIdx.x == 0) {
        unsigned* bar = b.bar;
        __builtin_amdgcn_s_waitcnt(0);
        unsigned nloc = b.st[0], nx = b.st[1];
        if (nloc == 0u) { xcd_barrier_complete(bar, b.x, nloc, nx); b.st[0] = nloc; b.st[1] = nx; }
        const unsigned old = xb_add(&bar[XB_XSUB(b.x)], 1u);
        const unsigned gen = old / nloc;
        if (old + 1u == (gen + 1u) * nloc) {
            __builtin_amdgcn_fence(__ATOMIC_RELEASE, "agent");
            asm volatile("s_waitcnt vmcnt(0)" ::: "memory");
            const unsigned og = xb_add(&bar[XB_TOP], 1u);
            const unsigned tg = og / nx;
            if (og + 1u == (tg + 1u) * nx) xb_add(&bar[XB_TOPGEN], 1u);
            else XB_SPIN(xb_ld(&bar[XB_TOPGEN]) == tg, bar);
            __builtin_amdgcn_fence(__ATOMIC_ACQUIRE, "agent");
            xb_add(&bar[XB_XGEN(b.x)], 1u);
            asm volatile("s_waitcnt vmcnt(0)" ::: "memory");
        } else {
            XB_SPIN(xb_ld(&bar[XB_XGEN(b.x)]) == gen, bar);
            __builtin_amdgcn_fence(__ATOMIC_ACQUIRE, "agent");
            asm volatile("s_waitcnt vmcnt(0)" ::: "memory");
        }
    }
    __syncthreads();
}


typedef unsigned short bf16;
typedef unsigned u32x4 __attribute__((ext_vector_type(4)));
typedef unsigned u32x2 __attribute__((ext_vector_type(2)));
typedef float f32x4 __attribute__((ext_vector_type(4)));
typedef float f32x16 __attribute__((ext_vector_type(16)));
typedef short bf16x8 __attribute__((ext_vector_type(8)));
typedef short s16x4 __attribute__((ext_vector_type(4)));
using pg8::cvtpk; using pg8::pack8;

struct Args {
    const float *x_prompt, *x_sample, *cache_pool, *cache_k, *cache_v, *c_prompt, *c_sample, *w_ada, *b_ada, *g_mix, *w_in, *pool_w, *pool_scale, *sinks, *w_out, *g_ffn, *w_gate_up, *w_down, *g_final;
    float* out; unsigned char* ws;
};

__device__ __forceinline__ float wave_sum(float v) {
#pragma unroll
    for (int o = 1; o < 64; o <<= 1) v += __shfl_xor(v, o);
    return v;
}
__device__ __forceinline__ int crow(int r, int hi) { return (r & 3) + 8 * (r >> 2) + 4 * hi; }
__device__ __forceinline__ float bf_lo(unsigned w) { return __uint_as_float(w << 16); }
__device__ __forceinline__ float bf_hi(unsigned w) { return __uint_as_float(w & 0xffff0000u); }
__device__ __forceinline__ float silu_f(float v) { return v * __builtin_amdgcn_rcpf(1.0f + __builtin_amdgcn_exp2f(-LOG2E * v)); }

__device__ __forceinline__ void transpose_item(const float* W, int ldw, bf16* WT, int ldt, int out_row0, int out_col0, LAS float* scr, int lane) {
    f32x4 v[16];
#pragma unroll
    for (int i = 0; i < 16; ++i) v[i] = *(const f32x4*)(W + (size_t)(4 * i + (lane >> 4)) * ldw + 4 * (lane & 15));
    const int c = lane & 7;
#pragma unroll
    for (int p = 0; p < 2; ++p) {
        if (((lane & 15) >> 3) == p) {
#pragma unroll
            for (int i = 0; i < 16; ++i) { LAS float* s = scr + (4 * i + (lane >> 4)) * 33 + 4 * (lane & 7); s[0] = v[i][0]; s[1] = v[i][1]; s[2] = v[i][2]; s[3] = v[i][3]; } }
        asm volatile("s_waitcnt lgkmcnt(0)" ::: "memory");
#pragma unroll
        for (int j = 0; j < 4; ++j) { const int n = (lane >> 3) + 8 * j; const LAS float* s = scr + (8 * c) * 33 + n;
            u32x4 o; o.x = cvtpk(s[0 * 33], s[1 * 33]); o.y = cvtpk(s[2 * 33], s[3 * 33]); o.z = cvtpk(s[4 * 33], s[5 * 33]); o.w = cvtpk(s[6 * 33], s[7 * 33]);
            *(u32x4*)(WT + (size_t)(out_row0 + 32 * p + n) * ldt + out_col0 + 8 * c) = o; }
        asm volatile("s_waitcnt lgkmcnt(0)" ::: "memory");
    }
}
__device__ __forceinline__ int grab(LAS unsigned* ctr, int lane) { unsigned v = 0u; if (lane == 0) v = __hip_atomic_fetch_add(ctr, 1u, __ATOMIC_RELAXED, __HIP_MEMORY_SCOPE_WORKGROUP); return (int)__builtin_amdgcn_readfirstlane(v) * (int)gridDim.x + (int)blockIdx.x; }

#define MFMA_BF(a, b, c) __builtin_amdgcn_mfma_f32_32x32x16_bf16((a), (b), (c), 0, 0, 0)
#define MFMA_F32(a, b, c) __builtin_amdgcn_mfma_f32_32x32x2f32((a), (b), (c), 0, 0, 0)
template <class LA, class LB>
__device__ __forceinline__ void sgemm64_1(int kb, int ke, const LA& la, const LB& lb, f32x16& c0, f32x16& c1, int lane) {
    const int r = lane & 31, h = lane >> 5;
#pragma unroll
    for (int i = 0; i < 16; ++i) { c0[i] = 0.f; c1[i] = 0.f; }
    f32x4 a0[4], a1[4], p0[4], p1[4]; float b[4][4], q[4][4];
#define SG_LOAD(A0, A1, B, kk) do { _Pragma("unroll") for (int u = 0; u < 4; ++u) { const int k = (kk) + 8 * u + 4 * h; A0[u] = la(0, r, k); A1[u] = la(1, r, k); _Pragma("unroll") for (int j = 0; j < 4; ++j) B[u][j] = lb(k + j, r); } } while (0)
#define SG_MMA(A0, A1, B) do { _Pragma("unroll") for (int u = 0; u < 4; ++u) _Pragma("unroll") for (int j = 0; j < 4; ++j) { c0 = MFMA_F32(A0[u][j], B[u][j], c0); c1 = MFMA_F32(A1[u][j], B[u][j], c1); } } while (0)
    SG_LOAD(a0, a1, b, kb);
    for (int k0 = kb; k0 < ke; k0 += 64) {
        SG_LOAD(p0, p1, q, k0 + 32);
        SG_MMA(a0, a1, b);
        if (k0 + 64 < ke) SG_LOAD(a0, a1, b, k0 + 64);
        SG_MMA(p0, p1, q);
    }
#undef SG_LOAD
#undef SG_MMA
}
template <int NB, class LA, class LB>
__device__ __forceinline__ void sgemm64(int kb, int ke, const LA& la, const LB& lb, f32x16 (&c)[NB][2], int lane) {
    constexpr int SUB = NB == 1 ? 4 : 2;
    const int r = lane & 31, h = lane >> 5;
#pragma unroll
    for (int nb = 0; nb < NB; ++nb)
#pragma unroll
        for (int i = 0; i < 16; ++i) { c[nb][0][i] = 0.f; c[nb][1][i] = 0.f; }
    f32x4 a0[SUB], a1[SUB], p0[SUB], p1[SUB]; float b[NB][SUB][4], q[NB][SUB][4];
#define SG_LOAD(A0, A1, B, kk) do { _Pragma("unroll") for (int u = 0; u < SUB; ++u) { const int k = (kk) + 8 * u + 4 * h; A0[u] = la(0, r, k); A1[u] = la(1, r, k); _Pragma("unroll") for (int nb = 0; nb < NB; ++nb) _Pragma("unroll") for (int j = 0; j < 4; ++j) B[nb][u][j] = lb(k + j, r + 32 * nb); } } while (0)
#define SG_MMA(A0, A1, B) do { _Pragma("unroll") for (int u = 0; u < SUB; ++u) _Pragma("unroll") for (int j = 0; j < 4; ++j) _Pragma("unroll") for (int nb = 0; nb < NB; ++nb) { c[nb][0] = MFMA_F32(A0[u][j], B[nb][u][j], c[nb][0]); c[nb][1] = MFMA_F32(A1[u][j], B[nb][u][j], c[nb][1]); } } while (0)
    SG_LOAD(a0, a1, b, kb);
    for (int k0 = kb; k0 < ke; k0 += 16 * SUB) {
        SG_LOAD(p0, p1, q, k0 + 8 * SUB);
        SG_MMA(a0, a1, b);
        if (k0 + 16 * SUB < ke) SG_LOAD(a0, a1, b, k0 + 16 * SUB);
        SG_MMA(p0, p1, q);
    }
#undef SG_LOAD
#undef SG_MMA
}
template <class LA, class LB>
__device__ __forceinline__ void wg_sgemm64x2(LAS unsigned char* lds, int K, const LA& la, const LB& lb, float* out, int ld, const float* addp, int lane, int wave) {
    f32x16 c[2][2]; sgemm64<2>(wave * (K >> 3), (wave + 1) * (K >> 3), la, lb, c, lane);
    LAS float* red = (LAS float*)lds;
#pragma unroll
    for (int nb = 0; nb < 2; ++nb)
#pragma unroll
        for (int blk = 0; blk < 2; ++blk)
#pragma unroll
            for (int i = 0; i < 16; ++i) red[(wave * 64 + nb * 32 + blk * 16 + i) * 64 + lane] = c[nb][blk][i];
    __syncthreads();
    const int h = lane >> 5;
#pragma unroll
    for (int j = 0; j < 8; ++j) { const int i = 8 * wave + j, nb = i >> 5, blk = (i >> 4) & 1, reg = i & 15; float s = 0.f;
#pragma unroll
        for (int p = 0; p < 8; ++p) s += red[(p * 64 + i) * 64 + lane];
        const int col = 32 * nb + (lane & 31); out[(size_t)(32 * blk + crow(reg, h)) * ld + col] = s + (addp ? addp[col] : 0.f); }
    __syncthreads();
}
struct LA_silu { const float* cp; const float* cs; __device__ __forceinline__ f32x4 operator()(int blk, int r, int k) const { const f32x4 v = *(const f32x4*)((blk ? cs : cp) + (size_t)r * DM + k); return (f32x4){silu_f(v[0]), silu_f(v[1]), silu_f(v[2]), silu_f(v[3])}; } };
struct LA_rows { const float* A; int lda; __device__ __forceinline__ f32x4 operator()(int blk, int r, int k) const { return *(const f32x4*)(A + (size_t)(32 * blk + r) * lda + k); } };
struct LB_plain { const float* B; int ldb; __device__ __forceinline__ float operator()(int k, int r) const { return B[(size_t)k * ldb + r]; } };
struct LB_scaled { const float* B; int ldb; const float* s; __device__ __forceinline__ float operator()(int k, int r) const { return B[(size_t)k * ldb + r] * s[k]; } };

__device__ __forceinline__ void phase0a(const Args& a, LAS unsigned char* lds, int tid, int lane, int wave, int cw = 16) {
    const int gw = blockIdx.x * 8 + wave, NGW = gridDim.x * 8, r = lane & 31, h = lane >> 5;
    LAS float* scr = (LAS float*)(lds + wave * 16384);
    float* mod = (float*)(a.ws + WS_MOD);
    bf16 *WinT = (bf16*)(a.ws + WS_WIN), *WoT = (bf16*)(a.ws + WS_WO), *WguT = (bf16*)(a.ws + WS_WGU), *WdT = (bf16*)(a.ws + WS_WD);
    constexpr int I_MOD = DEPTH * (6 * DM / 64), I_FOLD = DEPTH * 4 * 2 * (DM / 32);
    constexpr int T_IN = (DM / 64) * (INW / 64), T_OB = (512 / 64) * (DM / 64), T_GU = (DM / 64) * (NGU / 64), T_D = (DFF / 64) * (DM / 64), T_L = T_IN + T_OB + T_GU + T_D;
    constexpr int NITEMS = I_MOD + I_FOLD + DEPTH * T_L;
    for (int q = blockIdx.x; q < I_MOD; q += gridDim.x) {
        const int l = q / (6 * DM / 64), n0 = (q % (6 * DM / 64)) * 64;
        wg_sgemm64x2(lds, DM, LA_silu{a.c_prompt, a.c_sample}, LB_plain{a.w_ada + (size_t)l * DM * 6 * DM + n0, 6 * DM}, mod + (size_t)l * NSEQ * 6 * DM + n0, 6 * DM, a.b_ada + l * 6 * DM + n0, lane, wave);
    }
    LAS unsigned* ctr = (LAS unsigned*)(lds + XB_LDS_OFF) + cw;
    for (int it = grab(ctr, lane); it < NITEMS - I_MOD; it = grab(ctr, lane)) {
        int q = it; int ln = lane; asm volatile("" : "+v"(ln));
        if (q < I_FOLD) {
            const int nb = q % (DM / 32), half = (q / (DM / 32)) & 1, g = (q / (2 * DM / 32)) & 3, l = q / (8 * DM / 32), n0 = nb * 32;
            f32x16 c0, c1; sgemm64_1(0, 128, LA_rows{a.pool_w + ((size_t)(l * 4 + g) * 128 + half * 64) * 128, 128}, LB_scaled{a.w_out + ((size_t)l * DM + g * 128) * DM + n0, DM, a.pool_scale + l * PW + g * 128}, c0, c1, lane);
            bf16* wo = WoT + ((size_t)l * DM + n0 + r) * DM + g * 128 + half * 64 + 4 * h;
#pragma unroll
            for (int ig = 0; ig < 4; ++ig) { u32x2 w0, w1; w0.x = cvtpk(c0[4 * ig], c0[4 * ig + 1]); w0.y = cvtpk(c0[4 * ig + 2], c0[4 * ig + 3]); w1.x = cvtpk(c1[4 * ig], c1[4 * ig + 1]); w1.y = cvtpk(c1[4 * ig + 2], c1[4 * ig + 3]);
                *(u32x2*)(wo + 8 * ig) = w0; *(u32x2*)(wo + 32 + 8 * ig) = w1; }
            continue; }
        q -= I_FOLD;
        const int l = q / T_L; q -= l * T_L;
        if (q < T_IN) { const int kb = q / (INW / 64), nb = q % (INW / 64); transpose_item(a.w_in + ((size_t)l * DM + 64 * kb) * INW + 64 * nb, INW, WinT + (size_t)l * INW * DM, DM, 64 * nb, 64 * kb, scr, ln); continue; }
        q -= T_IN;
        if (q < T_OB) { const int kb = q / (DM / 64), nb = q % (DM / 64); transpose_item(a.w_out + ((size_t)l * DM + 512 + 64 * kb) * DM + 64 * nb, DM, WoT + (size_t)l * DM * DM, DM, 64 * nb, 512 + 64 * kb, scr, ln); continue; }
        q -= T_OB;
        if (q < T_GU) { const int kb = q / (NGU / 64), nb = q % (NGU / 64), o = 64 * nb, bj = o / DFF, rem = o - bj * DFF, orow = (rem >> 7) * 256 + bj * 128 + (rem & 127);
            transpose_item(a.w_gate_up + ((size_t)l * DM + 64 * kb) * NGU + o, NGU, WguT + (size_t)l * NGU * DM, DM, orow, 64 * kb, scr, ln); continue; }
        q -= T_GU;
        { const int kb = q / (DM / 64), nb = q % (DM / 64); transpose_item(a.w_down + ((size_t)l * DFF + 64 * kb) * DM + 64 * nb, DM, WdT + (size_t)l * DM * DFF, DFF, 64 * nb, 64 * kb, scr, ln); }
    }
    constexpr int CP4 = (WIN - DSEQ) * KVW / 4, NCP = DEPTH * 32 * 2 * CP4;
    for (int i = blockIdx.x * 512 + tid; i < NCP; i += gridDim.x * 512) {
        const int e = i % CP4, lb2 = i / CP4, kv = lb2 & 1, lb = lb2 >> 1;
        const f32x4 v = *(const f32x4*)((kv ? a.cache_v : a.cache_k) + ((size_t)lb * WIN + DSEQ) * KVW + 4 * e);
        *(f32x4*)(a.out + (kv ? O_VS : O_KS) + (size_t)lb * WIN * KVW + 4 * e) = v;
    }
}

__device__ __forceinline__ void phase0b(const Args& a, LAS unsigned char* lds, int tid, int lane, int wave, int cw = 17) {
    const int gw = blockIdx.x * 8 + wave, NGW = gridDim.x * 8, r = lane & 31, h = lane >> 5;
    const float* mod = (const float*)(a.ws + WS_MOD);
    float *bin = (float*)(a.ws + WS_BIN), *bgu = (float*)(a.ws + WS_BGU);
    constexpr int I_BIN = DEPTH * (INW / 32), I_BGU = DEPTH * (NGU / 32);
    bf16* XN = (bf16*)(a.ws + WS_XN); float* rss = (float*)(a.ws + WS_RSS);
    LAS unsigned* ctr = (LAS unsigned*)(lds + XB_LDS_OFF) + cw;
    constexpr int RCH = 8, I_ROWS = MT / RCH;
    for (int it = grab(ctr, lane); it < I_BIN + I_BGU + I_ROWS; it = grab(ctr, lane)) {
        if (it < I_BIN + I_BGU) {
            const bool gu = it >= I_BIN; const int q = gu ? it - I_BIN : it, NW = gu ? NGU : INW, l = q / (NW / 32), n0 = (q % (NW / 32)) * 32;
            const bf16* wp = (const bf16*)(a.ws + (gu ? WS_WGU : WS_WIN)) + ((size_t)l * NW + n0 + r) * DM + 8 * h;
            const float* sp = mod + ((size_t)l * NSEQ + r) * 6 * DM + (gu ? 3 * DM : 0) + 8 * h;
            f32x16 c0, c1;
#pragma unroll
            for (int i = 0; i < 16; ++i) { c0[i] = 0.f; c1[i] = 0.f; }
#pragma unroll 4
            for (int kk = 0; kk < DM; kk += 16) {
                const bf16x8 w = *(const bf16x8*)(wp + kk);
#pragma unroll
                for (int blk = 0; blk < 2; ++blk) { const float* s = sp + (size_t)blk * 32 * 6 * DM + kk; const f32x4 s0 = *(const f32x4*)s, s1 = *(const f32x4*)(s + 4);
                    const u32x4 hi = pack8(s0, s1); f32x4 h0, h1; pg8::unpack8(hi, h0, h1); const u32x4 lo = pack8(s0 - h0, s1 - h1);
                    if (blk == 0) { c0 = MFMA_BF(w, __builtin_bit_cast(bf16x8, hi), c0); c0 = MFMA_BF(w, __builtin_bit_cast(bf16x8, lo), c0); }
                    else { c1 = MFMA_BF(w, __builtin_bit_cast(bf16x8, hi), c1); c1 = MFMA_BF(w, __builtin_bit_cast(bf16x8, lo), c1); } }
            }
            float* ob = (gu ? bgu : bin) + ((size_t)l * NSEQ + r) * NW + n0 + 4 * h;
#pragma unroll
            for (int ig = 0; ig < 4; ++ig) { *(f32x4*)(ob + 8 * ig) = (f32x4){c0[4 * ig], c0[4 * ig + 1], c0[4 * ig + 2], c0[4 * ig + 3]}; *(f32x4*)(ob + (size_t)32 * NW + 8 * ig) = (f32x4){c1[4 * ig], c1[4 * ig + 1], c1[4 * ig + 2], c1[4 * ig + 3]}; }
            continue;
        }
        {
            const int row0 = (it - I_BIN - I_BGU) * RCH;
            f32x4 gm[4];
#pragma unroll
            for (int j = 0; j < 4; ++j) gm[j] = *(const f32x4*)(a.g_mix + 4 * (lane + 64 * j));
#pragma unroll
            for (int rb = 0; rb < RCH; rb += 4) {
                f32x4 v[4][4];
#pragma unroll
                for (int rr = 0; rr < 4; ++rr) { const int row = row0 + rb + rr; const float* xr = row < MP ? a.x_prompt + (size_t)row * DM : a.x_sample + (size_t)(row - MP) * DM;
#pragma unroll
                    for (int j = 0; j < 4; ++j) v[rr][j] = *(const f32x4*)(xr + 4 * (lane + 64 * j)); }
#pragma unroll
                for (int rr = 0; rr < 4; ++rr) { const int row = row0 + rb + rr; const float* sc = mod + (size_t)pg8::row_seq(row) * 6 * DM + DM; float s = 0.f;
#pragma unroll
                    for (int j = 0; j < 4; ++j) s += (v[rr][j][0] * v[rr][j][0] + v[rr][j][1] * v[rr][j][1]) + (v[rr][j][2] * v[rr][j][2] + v[rr][j][3] * v[rr][j][3]);
                    s = wave_sum(s);
#pragma unroll
                    for (int j = 0; j < 4; ++j) { const int c = 4 * (lane + 64 * j); const f32x4 o = v[rr][j] * pg8::gm4(gm[j], *(const f32x4*)(sc + c));
                        u32x2 w; w.x = cvtpk(o[0], o[1]); w.y = cvtpk(o[2], o[3]); *(u32x2*)(XN + (size_t)row * DM + c) = w;
                    }
                    if (lane < 16) rss[(size_t)row * 16 + lane] = lane == 0 ? s : 0.f; }
            }
        }
    }
}

__device__ __forceinline__ void ld8(float (&o)[8], const bf16* p) { const u32x4 w = *(const u32x4*)p; o[0] = bf_lo(w.x); o[1] = bf_hi(w.x); o[2] = bf_lo(w.y); o[3] = bf_hi(w.y); o[4] = bf_lo(w.z); o[5] = bf_hi(w.z); o[6] = bf_lo(w.w); o[7] = bf_hi(w.w); }
__device__ __forceinline__ void pool_get(float (&o)[8], bool samp, int b, int t, int ch0, const bf16* U, const float* cpool) {
    if (t < 0) {
        if (samp) { const float* p = cpool + ((size_t)b * PH + (PH + t)) * PW + ch0; const f32x4 x = *(const f32x4*)p, y = *(const f32x4*)(p + 4); o[0] = x[0]; o[1] = x[1]; o[2] = x[2]; o[3] = x[3]; o[4] = y[0]; o[5] = y[1]; o[6] = y[2]; o[7] = y[3]; }
        else {
#pragma unroll
            for (int i = 0; i < 8; ++i) o[i] = 0.f; }
    } else ld8(o, U + ((size_t)(samp ? MP + b * DSEQ + t : b * SEQ + t)) * PW + ch0);
}
__device__ __forceinline__ void pool_phase(const Args& a, int l, int lane, int wave) {
    const int gw = blockIdx.x * 8 + wave, NGW = gridDim.x * 8;
    const bf16* U = (const bf16*)(a.ws + WS_U); bf16* MIX = (bf16*)(a.ws + WS_MIX);
    const float* cpool = a.cache_pool + (size_t)l * 32 * PH * PW;
    constexpr int NPB = MP / 16;
    for (int it = gw; it < 2 * (NPB + NBS); it += NGW) {
        const int hf = it & 1, blk = it >> 1; const bool samp = blk >= NPB;
        const int b = samp ? blk - NPB : blk >> 7, t0 = samp ? 0 : (blk & 127) * 16;
        const int ch = hf * 256 + lane * 4, wl = 1 + 2 * hf + (lane >> 5), w = 1 << wl;
        const size_t rowbase = samp ? (size_t)MP + b * DSEQ : (size_t)b * SEQ + t0;
        f32x4 S[31]; u32x2 raw[31];
#pragma unroll
        for (int i = 0; i < 31; ++i) {
            raw[i] = (u32x2){0u, 0u};
            if (samp && i < 15) S[i] = *(const f32x4*)(cpool + ((size_t)b * PH + i) * PW + ch);
            else if (samp || t0 - 15 + i >= 0) raw[i] = *(const u32x2*)(U + (rowbase + i - 15) * PW + ch);
        }
#pragma unroll
        for (int i = 0; i < 31; ++i) if (!(samp && i < 15)) S[i] = (f32x4){bf_lo(raw[i].x), bf_hi(raw[i].x), bf_lo(raw[i].y), bf_hi(raw[i].y)};
        f32x4 cur[16];
#pragma unroll
        for (int j = 0; j < 16; ++j) cur[j] = S[15 + j];
#pragma unroll
        for (int i = 30; i >= 1; --i) S[i] += S[i - 1];
        if (wl >= 2) {
#pragma unroll
            for (int i = 30; i >= 2; --i) S[i] += S[i - 2]; }
        if (wl >= 3) {
#pragma unroll
            for (int i = 30; i >= 4; --i) S[i] += S[i - 4]; }
        if (wl >= 4) {
#pragma unroll
            for (int i = 30; i >= 8; --i) S[i] += S[i - 8]; }
#pragma unroll
        for (int j = 0; j < 16; ++j) {
            const int t = t0 + j; const float inv = 1.0f / (float)((samp || t + 1 >= w) ? w : t + 1);
            const f32x4 d = S[15 + j] * inv - cur[j];
            u32x2 o; o.x = cvtpk(d[0], d[1]); o.y = cvtpk(d[2], d[3]);
            *(u32x2*)(MIX + (rowbase + j) * DM + ch) = o;
        }
    }
}

constexpr int KS_STRIDE = 144, VT_STRIDE = 408  , LDS_KS = 0, LDS_VT = 192 * KS_STRIDE;
__device__ __forceinline__ void attn_unit(const Args& a, LAS unsigned char* lds, int l, int unit, int tid, int lane, int wave) {
    const bf16 *Qb = (const bf16*)(a.ws + WS_Q), *Kb = (const bf16*)(a.ws + WS_K), *Vb = (const bf16*)(a.ws + WS_V); bf16* MIX = (bf16*)(a.ws + WS_MIX);
    const bool samp = unit < 2 * NBS;
    int b, c = 0, hkv;
    if (samp) { b = unit >> 1; hkv = unit & 1; } else { const int u2 = unit - 2 * NBS; hkv = u2 & 1; c = (u2 >> 1) & 31; b = u2 >> 6; }
    const int lo = samp ? 0 : (c >= 2 ? 0 : (2 - c) * 64), hi = samp ? WIN + DSEQ : 192;
    const u32x4 z4 = {0u, 0u, 0u, 0u};
    const int g = wave >> 1, th = wave & 1, r32 = lane & 31, h = lane >> 5;
    const int tok = 32 * th + r32; const bool rv = !samp || tok < DSEQ;
    const size_t qrow = samp ? (size_t)MP + b * DSEQ + (rv ? tok : 0) : (size_t)b * SEQ + c * 64 + tok;
    const int head = hkv * 4 + g;
    bf16x8 qr[4];
#pragma unroll
    for (int d0 = 0; d0 < 4; ++d0) { u32x4 q4 = z4; if (rv) q4 = *(const u32x4*)(Qb + qrow * AW + head * 64 + d0 * 16 + h * 8); qr[d0] = __builtin_bit_cast(bf16x8, q4); }
    __syncthreads();
    for (int p = tid; p < 192 * 8; p += 512) { const int slot = p >> 3, ch = p & 7; u32x4 val = z4;
        if (slot >= lo && slot < hi) {
            if (samp && slot < WIN) { const float* s = a.cache_k + ((((size_t)l * 32 + b) * WIN + slot) * 2 + hkv) * 64 + ch * 8; val = pack8(*(const f32x4*)s, *(const f32x4*)(s + 4)); }
            else { const size_t grow = samp ? (size_t)MP + b * DSEQ + (slot - WIN) : (size_t)b * SEQ + (c - 2) * 64 + slot; val = *(const u32x4*)(Kb + grow * KVW + hkv * 64 + ch * 8); } }
        *(LAS u32x4*)(lds + LDS_KS + slot * KS_STRIDE + ch * 16) = val; }
    for (int p = tid; p < 96 * 8; p += 512) { const int jp = p >> 3, ch = p & 7, slot = 2 * jp; u32x4 va = z4, vb = z4;
        if (slot >= lo && slot < hi) {
            if (samp && slot < WIN) { const float* s = a.cache_v + ((((size_t)l * 32 + b) * WIN + slot) * 2 + hkv) * 64 + ch * 8; va = pack8(*(const f32x4*)s, *(const f32x4*)(s + 4)); vb = pack8(*(const f32x4*)(s + 128), *(const f32x4*)(s + 132)); }
            else { const size_t grow = samp ? (size_t)MP + b * DSEQ + (slot - WIN) : (size_t)b * SEQ + (c - 2) * 64 + slot; const bf16* s = Vb + grow * KVW + hkv * 64 + ch * 8; va = *(const u32x4*)s; vb = *(const u32x4*)(s + KVW); } }
        LAS unsigned* vt = (LAS unsigned*)(lds + LDS_VT + (ch * 8) * VT_STRIDE + jp * 4);
#pragma unroll
        for (int i = 0; i < 4; ++i) { const unsigned wa = va[i], wb = vb[i];
            vt[(2 * i) * (VT_STRIDE / 4)] = (wa & 0xffffu) | (wb << 16); vt[(2 * i + 1) * (VT_STRIDE / 4)] = (wa >> 16) | (wb & 0xffff0000u); } }
    __syncthreads();
    if (samp && th == 1) return;
    f32x16 s[6];
#pragma unroll
    for (int blk = 0; blk < 6; ++blk) {
#pragma unroll
        for (int i = 0; i < 16; ++i) s[blk][i] = 0.f;
#pragma unroll
        for (int d0 = 0; d0 < 4; ++d0) { const bf16x8 kf = *(const LAS bf16x8*)(lds + LDS_KS + (32 * blk + r32) * KS_STRIDE + d0 * 32 + h * 16); s[blk] = MFMA_BF(kf, qr[d0], s[blk]); }
        __builtin_amdgcn_sched_barrier(0);
    }
    const float sink2 = a.sinks[l * 8 + head] * LOG2E;
    if (lo > 0 || hi < 192) {
#pragma unroll
        for (int blk = 0; blk < 6; ++blk)
#pragma unroll
            for (int i = 0; i < 16; ++i) { const int slot = 32 * blk + crow(i, h); if (slot < lo || slot >= hi) s[blk][i] = -INFINITY; }
    }
    float mx = sink2;
#pragma unroll
    for (int blk = 0; blk < 6; ++blk)
#pragma unroll
        for (int i = 0; i < 16; ++i) mx = fmaxf(mx, s[blk][i]);
    mx = fmaxf(mx, __shfl_xor(mx, 32));
    float sum = 0.f; f32x4 sum4 = {0.f, 0.f, 0.f, 0.f}; u32x4 pk[12];
#pragma unroll
    for (int blk = 0; blk < 6; ++blk) {
        s[blk] = s[blk] - mx;
#pragma unroll
        for (int i = 0; i < 16; ++i) s[blk][i] = __builtin_amdgcn_exp2f(s[blk][i]);
        sum4 += ((f32x4){s[blk][0], s[blk][1], s[blk][2], s[blk][3]} + (f32x4){s[blk][4], s[blk][5], s[blk][6], s[blk][7]}) + ((f32x4){s[blk][8], s[blk][9], s[blk][10], s[blk][11]} + (f32x4){s[blk][12], s[blk][13], s[blk][14], s[blk][15]});
#pragma unroll
        for (int s2 = 0; s2 < 2; ++s2) { pk[2 * blk + s2].x = cvtpk(s[blk][8 * s2], s[blk][8 * s2 + 1]); pk[2 * blk + s2].y = cvtpk(s[blk][8 * s2 + 2], s[blk][8 * s2 + 3]); pk[2 * blk + s2].z = cvtpk(s[blk][8 * s2 + 4], s[blk][8 * s2 + 5]); pk[2 * blk + s2].w = cvtpk(s[blk][8 * s2 + 6], s[blk][8 * s2 + 7]); }
        __builtin_amdgcn_sched_barrier(0);
    }
    sum = (sum4[0] + sum4[1]) + (sum4[2] + sum4[3]);
    sum += __shfl_xor(sum, 32);
    const float inv = 1.0f / (sum + __builtin_amdgcn_exp2f(sink2 - mx));
    if (rv || true) {
        bf16* op = MIX + qrow * DM + 512 + head * 64 + 4 * h;
#pragma unroll
        for (int db = 0; db < 2; ++db) {
            f32x16 o;
#pragma unroll
            for (int i = 0; i < 16; ++i) o[i] = 0.f;
#pragma unroll
            for (int blk = 0; blk < 6; ++blk)
#pragma unroll
                for (int s2 = 0; s2 < 2; ++s2) {
                    const bf16x8 pf = __builtin_bit_cast(bf16x8, pk[2 * blk + s2]);
                    const LAS unsigned char* vp = lds + LDS_VT + (32 * db + r32) * VT_STRIDE + (32 * blk + 16 * s2 + 4 * h) * 2;
                    const s16x4 vlo = *(const LAS s16x4*)vp, vhi = *(const LAS s16x4*)(vp + 16);
                    const bf16x8 vf = {vlo[0], vlo[1], vlo[2], vlo[3], vhi[0], vhi[1], vhi[2], vhi[3]};
                    o = MFMA_BF(vf, pf, o);
                    __builtin_amdgcn_sched_barrier(0);
                }
            if (rv) {
#pragma unroll
                for (int ig = 0; ig < 4; ++ig) { u32x2 w; w.x = cvtpk(o[4 * ig] * inv, o[4 * ig + 1] * inv); w.y = cvtpk(o[4 * ig + 2] * inv, o[4 * ig + 3] * inv); *(u32x2*)(op + 32 * db + 8 * ig) = w; } }
        }
    }
}

__device__ __forceinline__ void state_phase(const Args& a, int l, int tid) {
    const bf16 *U = (const bf16*)(a.ws + WS_U), *Kb = (const bf16*)(a.ws + WS_K), *Vb = (const bf16*)(a.ws + WS_V);
    constexpr int N_PP = 32 * PH * (PW / 8), N_KP = 32 * WIN * (KVW / 8), N_PS = 32 * PH * (PW / 8), N_KS = 32 * DSEQ * (KVW / 8), NTOT = N_PP + 2 * N_KP + N_PS + 2 * N_KS;
    for (int i = blockIdx.x * 512 + tid; i < NTOT; i += gridDim.x * 512) {
        int q = i; const bf16* src; float* dst;
        if (q < N_PP) { const int c8 = q % (PW / 8), t = (q / (PW / 8)) % PH, b = q / (PW / 8 * PH);
            src = U + ((size_t)b * SEQ + (SEQ - PH) + t) * PW + 8 * c8; dst = a.out + O_POOLP + (((size_t)l * 32 + b) * PH + t) * PW + 8 * c8; }
        else if ((q -= N_PP) < 2 * N_KP) { const int kv = q >= N_KP; if (kv) q -= N_KP; const int c8 = q % (KVW / 8), t = (q / (KVW / 8)) % WIN, b = q / (KVW / 8 * WIN);
            src = (kv ? Vb : Kb) + ((size_t)b * SEQ + (SEQ - WIN) + t) * KVW + 8 * c8; dst = a.out + (kv ? O_VP : O_KP) + (((size_t)l * 32 + b) * WIN + t) * KVW + 8 * c8; }
        else if ((q -= 2 * N_KP) < N_PS) { const int c8 = q % (PW / 8), t = (q / (PW / 8)) % PH, b = q / (PW / 8 * PH);
            src = U + ((size_t)MP + b * DSEQ + 1 + t) * PW + 8 * c8; dst = a.out + O_POOLS + (((size_t)l * 32 + b) * PH + t) * PW + 8 * c8; }
        else { q -= N_PS; const int kv = q >= N_KS; if (kv) q -= N_KS; const int c8 = q % (KVW / 8), t = (q / (KVW / 8)) % DSEQ, b = q / (KVW / 8 * DSEQ);
            src = (kv ? Vb : Kb) + ((size_t)MP + b * DSEQ + t) * KVW + 8 * c8; dst = a.out + (kv ? O_VS : O_KS) + (((size_t)l * 32 + b) * WIN + (WIN - DSEQ) + t) * KVW + 8 * c8; }
        float v[8]; ld8(v, src);
        *(f32x4*)dst = (f32x4){v[0], v[1], v[2], v[3]}; *(f32x4*)(dst + 4) = (f32x4){v[4], v[5], v[6], v[7]};
    }
}


template <int KS, class F>
__device__ __forceinline__ void side_gemm(LAS unsigned char* lds, const bf16* A, const bf16* Bt, int K, int ncp, const F& f, int tid, int wave) {
    constexpr int NSUB = 8 / KS;
    const int lane = tid & 63, r = lane & 31, h = lane >> 5, kc = wave & (KS - 1), sub = wave / KS, nitems = (MS / 32) * ncp, Kc = K / KS;
    LAS float* red = (LAS float*)lds + sub * (3 * 32 * 64);
    for (int it0 = blockIdx.x * NSUB; it0 < nitems; it0 += gridDim.x * NSUB) {
        const int it = it0 + sub; const bool act = it < nitems; const int rb = it & 15, cp = it >> 4;
        f32x16 c0, c1;
#pragma unroll
        for (int i = 0; i < 16; ++i) { c0[i] = 0.f; c1[i] = 0.f; }
        if (act) {
            const bf16* ap = A + (size_t)(rb * 32 + r) * K + kc * Kc + 8 * h;
            const bf16* b0 = Bt + (size_t)((cp >> 2) * 256 + (cp & 3) * 32 + r) * K + kc * Kc + 8 * h; const bf16* b1 = b0 + (size_t)128 * K;
#pragma unroll (KS == 1 ? 16 : 8)
            for (int k = 0; k < Kc; k += 16) { const bf16x8 af = *(const bf16x8*)(ap + k), w0 = *(const bf16x8*)(b0 + k), w1 = *(const bf16x8*)(b1 + k); c0 = MFMA_BF(w0, af, c0); c1 = MFMA_BF(w1, af, c1); }
            if (KS > 1 && kc != 0) {
#pragma unroll
                for (int i = 0; i < 16; ++i) { red[((kc - 1) * 32 + i) * 64 + lane] = c0[i]; red[((kc - 1) * 32 + 16 + i) * 64 + lane] = c1[i]; } }
        }
        if (KS > 1) __syncthreads();
        if (act && kc == 0) {
            if (KS > 1) {
#pragma unroll
                for (int p = 0; p < KS - 1; ++p)
#pragma unroll
                    for (int i = 0; i < 16; ++i) { c0[i] += red[(p * 32 + i) * 64 + lane]; c1[i] += red[(p * 32 + 16 + i) * 64 + lane]; } }
            f(MP + rb * 32 + r, h, cp, c0, c1);
        }
        if (KS > 1) __syncthreads();
    }
    if (KS == 1) __syncthreads();
}
#define V4(c, ig) ((f32x4){c[4 * (ig)], c[4 * (ig) + 1], c[4 * (ig) + 2], c[4 * (ig) + 3]})
__device__ __forceinline__ u32x2 pack4(f32x4 v) { u32x2 w; w.x = cvtpk(v[0], v[1]); w.y = cvtpk(v[2], v[3]); return w; }
__device__ __forceinline__ float row_rstd(const float* rss, int row) { const f32x4* p = (const f32x4*)(rss + (size_t)row * 16); const f32x4 a = p[0], b = p[1], c = p[2], d = p[3];
    return rsqrtf((((a[0] + a[1]) + (a[2] + a[3])) + ((b[0] + b[1]) + (b[2] + b[3])) + ((c[0] + c[1]) + (c[2] + c[3])) + ((d[0] + d[1]) + (d[2] + d[3]))) * (1.0f / DM) + EPS); }
struct SIn { const float* rss; const float* bias; bf16 *U, *Q, *K, *V;
    __device__ __forceinline__ void operator()(int row, int h, int cp, const f32x16& c0, const f32x16& c1) const {
        const int pn = cp >> 2, cb = pn * 256 + (cp & 3) * 32 + 4 * h; bf16 *d0, *d1; int pitch; float sc = 1.f;
        if (pn < 2) { d0 = U + cb; d1 = d0 + 128; pitch = PW; } else if (pn < 4) { d0 = Q + (cb - 512); d1 = d0 + 128; pitch = AW; sc = QSCALE; } else { d0 = K + (cb - 1024); d1 = V + (cb - 1024); pitch = KVW; }
        const float rs = row_rstd(rss, row) * sc; const float* bp = bias + (size_t)pg8::row_seq(row) * INW + cb;
#pragma unroll
        for (int ig = 0; ig < 4; ++ig) { *(u32x2*)(d0 + (size_t)row * pitch + 8 * ig) = pack4(V4(c0, ig) * rs + *(const f32x4*)(bp + 8 * ig) * sc); *(u32x2*)(d1 + (size_t)row * pitch + 8 * ig) = pack4(V4(c1, ig) * rs + *(const f32x4*)(bp + 128 + 8 * ig) * sc); }
    } };
struct SRes { bf16* xn; const float* gate; const float* psc; const float* pg; const float* nsc; const float* ng; float* rss;
    __device__ __forceinline__ void operator()(int row, int h, int cp, const f32x16& c0, const f32x16& c1) const {
        const int cb = (cp >> 2) * 256 + (cp & 3) * 32 + 4 * h; const size_t so = (size_t)pg8::row_seq(row) * (6 * DM); float ss = 0.f;
#pragma unroll
        for (int hb = 0; hb < 2; ++hb)
#pragma unroll
            for (int ig = 0; ig < 4; ++ig) { const int c = cb + hb * 128 + 8 * ig; const u32x2 w = *(const u32x2*)(xn + (size_t)row * DM + c);
                const f32x4 x = (f32x4){bf_lo(w.x), bf_hi(w.x), bf_lo(w.y), bf_hi(w.y)} * (1.0f / pg8::gm4(*(const f32x4*)(pg + c), *(const f32x4*)(psc + so + c))) + *(const f32x4*)(gate + so + c) * (hb ? V4(c1, ig) : V4(c0, ig));
                ss += (x[0] * x[0] + x[1] * x[1]) + (x[2] * x[2] + x[3] * x[3]);
                *(u32x2*)(xn + (size_t)row * DM + c) = pack4(nsc ? x * pg8::gm4(*(const f32x4*)(ng + c), *(const f32x4*)(nsc + so + c)) : x); }
        ss += __shfl_xor(ss, 32); if (h == 0) rss[(size_t)row * 16 + cp] = ss;
    } };
struct SGU { const float* rss; const float* bias; bf16* H;
    __device__ __forceinline__ void operator()(int row, int h, int cp, const f32x16& c0, const f32x16& c1) const {
        const int pn = cp >> 2, wc = cp & 3; const float rs = row_rstd(rss, row); const float* bp = bias + (size_t)pg8::row_seq(row) * NGU + pn * 256 + wc * 32 + 4 * h;
#pragma unroll
        for (int ig = 0; ig < 4; ++ig) { const f32x4 a = V4(c0, ig) * rs + *(const f32x4*)(bp + 8 * ig), b = V4(c1, ig) * rs + *(const f32x4*)(bp + 128 + 8 * ig); f32x4 o;
#pragma unroll
            for (int i = 0; i < 4; ++i) o[i] = a[i] * b[i] * __builtin_amdgcn_rcpf(1.0f + __builtin_amdgcn_exp2f(-LOG2E * a[i]));
            *(u32x2*)(H + (size_t)row * DFF + pn * 128 + wc * 32 + 4 * h + 8 * ig) = pack4(o); }
    } };

#define CAS __attribute__((address_space(4)))
__device__ __forceinline__ Args load_args(const CAS Args* p) {
#if defined(__HIP_DEVICE_COMPILE__)
    asm volatile("" : "+s"(p)); Args r; const CAS unsigned long long* q = (const CAS unsigned long long*)p; const float** d = (const float**)&r;
#pragma unroll
    for (int i = 0; i < (int)(sizeof(Args) / 8); ++i) d[i] = (const float*)(const __attribute__((address_space(1))) float*)q[i];
    return r;
#else
    return Args{};
#endif
}
__device__ __forceinline__ int mk_tid(int wave) { unsigned z; asm volatile("s_mov_b32 %0, 0" : "=s"(z)); return wave * 64 + (int)__builtin_amdgcn_mbcnt_hi(~0u, __builtin_amdgcn_mbcnt_lo(~0u, z)); }
__global__ void __launch_bounds__(512, 2) fwd_megakernel(Args a_kernarg) {
    extern __shared__ __attribute__((aligned(16))) unsigned char lds_raw[];
    LAS unsigned char* lds = (LAS unsigned char*)lds_raw;
    cg::grid_group grid = cg::this_grid();
    const CAS Args* ap = (const CAS Args*)__builtin_amdgcn_kernarg_segment_ptr();
    const int wave = __builtin_amdgcn_readfirstlane(threadIdx.x >> 6), G = gridDim.x, bx = blockIdx.x;
    if (threadIdx.x < 64) ((LAS unsigned*)(lds + XB_LDS_OFF))[threadIdx.x] = 0u;
    __syncthreads();
    { const Args a = load_args(ap); (void)xcd_barrier_post((unsigned*)(a.ws + WS_CTL), (volatile LAS unsigned*)(lds + XB_LDS_OFF)); }
#define GRID_BAR() do { const Args a_ = load_args(ap); XcdBarrier b_; b_.bar = (unsigned*)(a_.ws + WS_CTL); b_.x = xb_xcc_id(); b_.st = (volatile LAS unsigned*)(lds + XB_LDS_OFF); xcd_barrier(b_); } while (0)
#ifndef SKIP_P0
#if defined(PROBE_P0X2) || defined(PROBE_P0AX2)
    { const Args a = load_args(ap); const int tid = mk_tid(wave); phase0a(a, lds, tid, tid & 63, wave, 18); }
    GRID_BAR();
#endif
#ifdef PROBE_P0X2
    { const Args a = load_args(ap); const int tid = mk_tid(wave); phase0b(a, lds, tid, tid & 63, wave, 19); }
    GRID_BAR();
#endif
    { const Args a = load_args(ap); const int tid = mk_tid(wave); phase0a(a, lds, tid, tid & 63, wave); }
    grid.sync();
    { const Args a = load_args(ap); const int tid = mk_tid(wave); phase0b(a, lds, tid, tid & 63, wave); }
    GRID_BAR();
#endif
#pragma nounroll
    for (int l = 0; l < DEPTH; ++l) {
#ifndef SKIP_P1
        {
            const Args a = load_args(ap);
            { const int tid = mk_tid(wave); SIn F{(const float*)(a.ws + WS_RSS), (const float*)(a.ws + WS_BIN) + (size_t)l * NSEQ * INW, (bf16*)(a.ws + WS_U), (bf16*)(a.ws + WS_Q), (bf16*)(a.ws + WS_K), (bf16*)(a.ws + WS_V)};
              side_gemm<4>(lds, (const bf16*)(a.ws + WS_XN) + (size_t)MP * DM, (const bf16*)(a.ws + WS_WIN) + (size_t)l * INW * DM, DM, INW / 64, F, tid, wave); }
            pg8::Gemm g{(const bf16*)(a.ws + WS_XN), (const bf16*)(a.ws + WS_WIN) + (size_t)l * INW * DM, MP, INW, DM}; pg8::StaticOrder S; S.init(MP, INW, G, bx);
            pg8::EpiIn E{(const float*)(a.ws + WS_RSS), (const float*)(a.ws + WS_BIN) + (size_t)l * NSEQ * INW, (bf16*)(a.ws + WS_U), (bf16*)(a.ws + WS_Q), (bf16*)(a.ws + WS_K), (bf16*)(a.ws + WS_V)};
            pg8::gemm_phase<pg8::EpiIn, pg8::StaticOrder, true, true>(lds, g, S, E, mk_tid(wave));
#ifdef PROBE_P1X2
            asm volatile("" ::: "memory"); pg8::gemm_phase<pg8::EpiIn, pg8::StaticOrder, true, true>(lds, g, S, E, mk_tid(wave));
#endif
        }
#endif
        GRID_BAR();
#ifndef SKIP_P2
        {
            const Args a = load_args(ap); const int tid = mk_tid(wave), lane = tid & 63;
#ifdef PROBE_P2X2
            for (int rep = 0; rep < 2; ++rep) { asm volatile("" ::: "memory");
#endif
            state_phase(a, l, tid);
            pool_phase(a, l, lane, wave);
            for (int unit = bx; unit < 2 * NBS + NBP * 32 * 2; unit += G) attn_unit(a, lds, l, unit, tid, lane, wave);
            __syncthreads();
#ifdef PROBE_P2X2
            }
#endif
        }
#endif
        GRID_BAR();
#ifndef SKIP_P3
        {
            const Args a = load_args(ap);
            bf16* X = (bf16*)(a.ws + WS_XN); const float* modl = (const float*)(a.ws + WS_MOD) + (size_t)l * NSEQ * 6 * DM;
            { const int tid = mk_tid(wave); SRes F{X, modl + 2 * DM, modl + DM, a.g_mix + l * DM, modl + 4 * DM, a.g_ffn + l * DM, (float*)(a.ws + WS_RSS)};
              side_gemm<4>(lds, (const bf16*)(a.ws + WS_MIX) + (size_t)MP * DM, (const bf16*)(a.ws + WS_WO) + (size_t)l * DM * DM, DM, DM / 64, F, tid, wave); }
            pg8::Gemm g{(const bf16*)(a.ws + WS_MIX), (const bf16*)(a.ws + WS_WO) + (size_t)l * DM * DM, MP, DM, DM}; pg8::StaticOrder S; S.init(MP, DM, G, bx, 1);
            pg8::EpiRes E{X, modl + 2 * DM, modl + DM, a.g_mix + l * DM, modl + 4 * DM, a.g_ffn + l * DM, (float*)(a.ws + WS_RSS), (LAS float*)(lds + EPI_LDS_OFF)};
            pg8::gemm_phase<pg8::EpiRes, pg8::StaticOrder, true, true>(lds, g, S, E, mk_tid(wave));
        }
#endif
        GRID_BAR();
#ifndef SKIP_P4
        {
            const Args a = load_args(ap);
            { const int tid = mk_tid(wave); SGU F{(const float*)(a.ws + WS_RSS), (const float*)(a.ws + WS_BGU) + (size_t)l * NSEQ * NGU, (bf16*)(a.ws + WS_H)};
              side_gemm<1>(lds, (const bf16*)(a.ws + WS_XN) + (size_t)MP * DM, (const bf16*)(a.ws + WS_WGU) + (size_t)l * NGU * DM, DM, NGU / 64, F, tid, wave); }
            pg8::Gemm g{(const bf16*)(a.ws + WS_XN), (const bf16*)(a.ws + WS_WGU) + (size_t)l * NGU * DM, MP, NGU, DM}; pg8::StaticOrder S; S.init(MP, NGU, G, bx);
            pg8::EpiGU E{(const float*)(a.ws + WS_RSS), (const float*)(a.ws + WS_BGU) + (size_t)l * NSEQ * NGU, (bf16*)(a.ws + WS_H), (LAS float*)(lds + EGU_LDS_OFF)};
            pg8::gemm_phase<pg8::EpiGU, pg8::StaticOrder, true, true>(lds, g, S, E, mk_tid(wave));
#ifdef PROBE_P4X2
            asm volatile("" ::: "memory"); pg8::gemm_phase<pg8::EpiGU, pg8::StaticOrder, true, true>(lds, g, S, E, mk_tid(wave));
#endif
        }
#endif
        GRID_BAR();
#ifndef SKIP_P5
        {
            const Args a = load_args(ap);
            bf16* X = (bf16*)(a.ws + WS_XN); const float* modl = (const float*)(a.ws + WS_MOD) + (size_t)l * NSEQ * 6 * DM;
            const bool last = l == DEPTH - 1;
            { const int tid = mk_tid(wave); SRes F{X, modl + 5 * DM, modl + 4 * DM, a.g_ffn + l * DM, last ? nullptr : modl + NSEQ * 6 * DM + DM, a.g_mix + (last ? 0 : (l + 1) * DM), (float*)(a.ws + WS_RSS)};
              side_gemm<4>(lds, (const bf16*)(a.ws + WS_H) + (size_t)MP * DFF, (const bf16*)(a.ws + WS_WD) + (size_t)l * DM * DFF, DFF, DM / 64, F, tid, wave); }
            pg8::Gemm g{(const bf16*)(a.ws + WS_H), (const bf16*)(a.ws + WS_WD) + (size_t)l * DM * DFF, MP, DM, DFF}; pg8::StaticOrder S; S.init(MP, DM, G, bx, 1);
            pg8::EpiRes E{X, modl + 5 * DM, modl + 4 * DM, a.g_ffn + l * DM, last ? nullptr : modl + NSEQ * 6 * DM + DM, a.g_mix + (last ? 0 : (l + 1) * DM), (float*)(a.ws + WS_RSS), (LAS float*)(lds + EPI_LDS_OFF)};
            pg8::gemm_phase<pg8::EpiRes, pg8::StaticOrder, true, true>(lds, g, S, E, mk_tid(wave));
        }
#endif
        GRID_BAR();
    }
    {
        const Args a = load_args(ap); const int lane = mk_tid(wave) & 63;
        const bf16* X = (const bf16*)(a.ws + WS_XN); const float* rss = (const float*)(a.ws + WS_RSS);
        f32x4 g0[2], g1[2];
#pragma unroll
        for (int j = 0; j < 2; ++j) { g0[j] = *(const f32x4*)(a.g_final + 8 * (lane + 64 * j)); g1[j] = *(const f32x4*)(a.g_final + 8 * (lane + 64 * j) + 4); }
#pragma unroll 2
        for (int row = bx * 8 + wave; row < MT; row += G * 8) {
            const float pr = lane < 16 ? rss[(size_t)row * 16 + lane] : 0.f;
            const u32x4 w0 = *(const u32x4*)(X + (size_t)row * DM + 8 * lane), w1 = *(const u32x4*)(X + (size_t)row * DM + 8 * (lane + 64));
            const float rstd = rsqrtf(wave_sum(pr) * (1.0f / DM) + EPS);
            float* yr = a.out + (size_t)row * DM; f32x4 lo, hi;
            pg8::unpack8(w0, lo, hi); *(f32x4*)(yr + 8 * lane) = lo * rstd * g0[0]; *(f32x4*)(yr + 8 * lane + 4) = hi * rstd * g1[0];
            pg8::unpack8(w1, lo, hi); *(f32x4*)(yr + 8 * (lane + 64)) = lo * rstd * g0[1]; *(f32x4*)(yr + 8 * (lane + 64) + 4) = hi * rstd * g1[1];
        }
    }
}

extern "C" void kernel_launch(void* const* d_in, const int* in_sizes, int n_in, void* d_out, int out_size, void* d_ws, size_t ws_size, hipStream_t stream) {
    static int grid = 0;
    if (grid == 0) {
        if (n_in != 19 || (size_t)out_size != O_END || ws_size < WS_TOTAL) { fprintf(stderr, "kernel_launch: shape mismatch (n_in %d out %d ws %zu need %zu)\n", n_in, out_size, ws_size, (size_t)WS_TOTAL); grid = -1; return; }
        int dev = 0, cus = 0, per_cu = 0;
        hipGetDevice(&dev); hipDeviceGetAttribute(&cus, hipDeviceAttributeMultiprocessorCount, dev);
        if (hipFuncSetAttribute((const void*)fwd_megakernel, hipFuncAttributeMaxDynamicSharedMemorySize, LDS_BYTES) != hipSuccess) { fprintf(stderr, "kernel_launch: hipFuncSetAttribute failed\n"); grid = -1; return; }
        if (hipOccupancyMaxActiveBlocksPerMultiprocessor(&per_cu, (const void*)fwd_megakernel, 512, LDS_BYTES) != hipSuccess || per_cu < 1) { fprintf(stderr, "kernel_launch: occupancy query says %d\n", per_cu); per_cu = 1; }
        (void)hipGetLastError();
        grid = cus;
    }
    if (grid < 0) return;
    if (hipMemsetAsync((char*)d_ws + WS_CTL, 0, CTL_BYTES, stream) != hipSuccess) { fprintf(stderr, "kernel_launch: memset failed\n"); return; }
    Args a{};
    const float** f = (const float**)&a;
    for (int i = 0; i < 19; ++i) f[i] = (const float*)d_in[i];
    a.out = (float*)d_out; a.ws = (unsigned char*)d_ws;
    void* args[] = {&a};
    hipError_t e = hipLaunchCooperativeKernel((const void*)fwd_megakernel, dim3(grid), dim3(512), args, LDS_BYTES, stream);
    if (e != hipSuccess) fprintf(stderr, "kernel_launch: cooperative launch failed: %s (grid %d)\n", hipGetErrorString(e), grid);
}
```

```cpp
#include <hip/hip_runtime.h>
#include <hip/hip_cooperative_groups.h>
#include <cstdio>
#include <cstdint>
namespace cg = cooperative_groups;

constexpr int DM = 1024, NBP = 32, SEQ = 2048, DEPTH = 4, NBS = 32, DSEQ = 16;
constexpr int MP = NBP * SEQ, MS = NBS * DSEQ, MT = MP + MS;
constexpr int PW = 512, AW = 512, KVW = 128, INW = 1280, DFF = 2816, NGU = 2 * DFF, NSEQ = 64, WIN = 128, PH = 15;
constexpr float EPS = 1e-6f;
constexpr float QSCALE = 0.125f * 1.4426950408889634f;
constexpr float LOG2E = 1.4426950408889634f;
constexpr size_t O_YP = 0, O_YS = (size_t)MP * DM, O_POOLP = O_YS + (size_t)MS * DM, SZ_POOL = (size_t)DEPTH * 32 * PH * PW, SZ_KV = (size_t)DEPTH * 32 * WIN * KVW;
constexpr size_t O_KP = O_POOLP + SZ_POOL, O_VP = O_KP + SZ_KV, O_POOLS = O_VP + SZ_KV, O_KS = O_POOLS + SZ_POOL, O_VS = O_KS + SZ_KV, O_END = O_VS + SZ_KV;
constexpr size_t WS_WIN = 0, WS_WO = WS_WIN + (size_t)DEPTH * INW * DM * 2, WS_WGU = WS_WO + (size_t)DEPTH * DM * DM * 2, WS_WD = WS_WGU + (size_t)DEPTH * NGU * DM * 2;
constexpr size_t WS_MOD = WS_WD + (size_t)DEPTH * DM * DFF * 2, WS_BIN = WS_MOD + (size_t)DEPTH * NSEQ * 6 * DM * 4, WS_BGU = WS_BIN + (size_t)DEPTH * NSEQ * INW * 4;
constexpr size_t WS_RSS = WS_BGU + (size_t)DEPTH * NSEQ * NGU * 4, WS_XN = WS_RSS + (size_t)MT * 16 * 4, WS_U = WS_XN + (size_t)MT * DM * 2;
constexpr size_t WS_Q = WS_U + (size_t)MT * PW * 2, WS_K = WS_Q + (size_t)MT * AW * 2, WS_V = WS_K + (size_t)MT * KVW * 2, WS_MIX = WS_V + (size_t)MT * KVW * 2;
constexpr size_t WS_H = WS_U  , WS_END = WS_H + (size_t)MT * DFF * 2;
static_assert(WS_MIX + (size_t)MT * DM * 2 <= WS_END, "H overlay covers U..MIX");
constexpr size_t WS_CTL = (WS_END + 4095) / 4096 * 4096, CTL_BYTES = 16384;
constexpr size_t WS_TOTAL = WS_CTL + CTL_BYTES;
constexpr int LDS_BYTES = 147456, XB_LDS_OFF = 131072 + 1024, EPI_LDS_OFF = 131072 + 2048, EGU_LDS_OFF = EPI_LDS_OFF + 6144;

namespace pg8 {
#define PG8_LAS __attribute__((address_space(3)))
typedef unsigned short bf16_t;
typedef short bf16x8 __attribute__((ext_vector_type(8)));
typedef float f32x4 __attribute__((ext_vector_type(4)));
typedef unsigned u32x4 __attribute__((ext_vector_type(4)));
constexpr int BM = 256, BK = 64, HALF = 128, HTB = HALF * BK * 2  , STAGE_BYTES = 8 * HTB, NXCD = 8, WGM = 4;

__host__ __device__ __forceinline__ int lds_byte(int r, int c) { const int st = (r >> 4) * 2 + (c >> 5), rr = r & 15, cc = c & 31, ob = rr * 64 + cc * 2; return st * 1024 + (ob ^ (((ob >> 9) & 1) << 5)); }
__host__ __device__ __forceinline__ void stage_rc(int b, int& R, int& C) { const int st = b / 1024, sb = b % 1024, swz = sb ^ (((sb >> 9) & 1) << 5); R = (st >> 1) * 16 + swz / 64; C = (st & 1) * 32 + (swz % 64) / 2; }
__host__ __device__ __forceinline__ int perm32(int rho) { const int n = rho >> 4, i = rho & 15; return 8 * (i >> 2) + 4 * n + (i & 3); }

struct Unit { int pm, pn; };
struct Gemm { const bf16_t* A; const bf16_t* Bt; int M, N, K; };

struct StaticOrder {
    int nM, nN, nwg, G, c, rev;
    __host__ __device__ void init(int M, int N, int G_, int c_, int rev_ = 0) { nM = M / BM; nN = N / BM; nwg = nM * nN; G = G_; c = c_; rev = rev_; }
    __host__ __device__ bool next(int i, Unit& u) const {
        const long L = (long)i * G + c; if (L >= nwg) return false;
        int wgid = (int)L; { const int q = nwg / NXCD, r = nwg % NXCD, xcd = wgid % NXCD, off = wgid / NXCD; wgid = (xcd < r ? xcd * (q + 1) : r * (q + 1) + (xcd - r) * q) + off; }
        const int nig = WGM * nN, gid = wgid / nig, fm = gid * WGM, gsz = (nM - fm) < WGM ? (nM - fm) : WGM;
        u.pm = fm + ((wgid % nig) % gsz); u.pn = (wgid % nig) / gsz; if (rev) u.pm = (u.pm & ~31) | (31 - (u.pm & 31)); return true;
    }
    __device__ __forceinline__ void a_ready(const Unit&) const {}
    __device__ __forceinline__ void done(const Unit&) const {}
};


typedef float f32x2_t __attribute__((ext_vector_type(2))); typedef __bf16 bf16x2_t __attribute__((ext_vector_type(2)));
__device__ __forceinline__ unsigned cvtpk(float lo, float hi) { f32x2_t v = {lo, hi}; bf16x2_t b = __builtin_convertvector(v, bf16x2_t); return __builtin_bit_cast(unsigned, b); }
__device__ __forceinline__ u32x4 pack8(f32x4 a, f32x4 b) { u32x4 w; w.x = cvtpk(a[0], a[1]); w.y = cvtpk(a[2], a[3]); w.z = cvtpk(b[0], b[1]); w.w = cvtpk(b[2], b[3]); return w; }
__device__ __forceinline__ int row_seq(int row) { return row < MP ? (row >> 11) : 32 + ((row - MP) >> 4); }
__device__ __forceinline__ void load_rstd(float (&rs)[2][4], const float* rss, const Unit& u, int wr, int fr, int fq) {
#pragma unroll
    for (int ai = 0; ai < 2; ++ai)
#pragma unroll
        for (int m = 0; m < 4; ++m) { const int row = u.pm * BM + ai * HALF + wr * 64 + m * 16 + fr; const f32x4 p = *(const f32x4*)(rss + (size_t)row * 16 + fq * 4);
            float s = (p[0] + p[1]) + (p[2] + p[3]); s += __shfl_xor(s, 16); s += __shfl_xor(s, 32); rs[ai][m] = rsqrtf(s * (1.0f / DM) + EPS); }
}

struct EpiIn {
    static constexpr bool PERM = true, AFTER_DRAIN = false, WANTS_NEXT = false;
    const float* rss; const float* bias;
    bf16_t *U, *Q, *K, *V;
    __device__ __forceinline__ void operator()(const f32x4 (&acc)[2][2][4][2], const Unit& u, int wr, int wc, int fr, int fq) const {
        const int ct = u.pn * BM, cl = wc * 32 + 8 * fq;
        bf16_t *d0, *d1; int pitch; float sc = 1.f;
        if (ct < 512) { d0 = U + ct + cl; d1 = d0 + HALF; pitch = PW; }
        else if (ct < 1024) { d0 = Q + (ct - 512) + cl; d1 = d0 + HALF; pitch = AW; sc = QSCALE; }
        else { d0 = K + cl; d1 = V + cl; pitch = KVW; }
        const float* bp = bias + (size_t)(u.pm >> 3) * INW + ct + cl;
        float rs[2][4]; load_rstd(rs, rss, u, wr, fr, fq);
        const f32x4 b0 = *(const f32x4*)bp * sc, b1 = *(const f32x4*)(bp + 4) * sc, b2 = *(const f32x4*)(bp + HALF) * sc, b3 = *(const f32x4*)(bp + HALF + 4) * sc;
#pragma unroll
        for (int ai = 0; ai < 2; ++ai)
#pragma unroll
            for (int m = 0; m < 4; ++m) {
                const size_t ro = (size_t)(u.pm * BM + ai * HALF + wr * 64 + m * 16 + fr) * pitch; const float r = rs[ai][m] * sc;
                *(u32x4*)(d0 + ro) = pack8(acc[ai][0][m][0] * r + b0, acc[ai][0][m][1] * r + b1);
                *(u32x4*)(d1 + ro) = pack8(acc[ai][1][m][0] * r + b2, acc[ai][1][m][1] * r + b3);
            }
    }
};

__device__ __forceinline__ void unpack8(u32x4 w, f32x4& lo, f32x4& hi) {
    lo = (f32x4){__uint_as_float(w.x << 16), __uint_as_float(w.x & 0xffff0000u), __uint_as_float(w.y << 16), __uint_as_float(w.y & 0xffff0000u)};
    hi = (f32x4){__uint_as_float(w.z << 16), __uint_as_float(w.z & 0xffff0000u), __uint_as_float(w.w << 16), __uint_as_float(w.w & 0xffff0000u)}; }
__device__ __forceinline__ f32x4 gm4(f32x4 g, f32x4 sc) { f32x4 v = g * (sc + 1.0f);
#pragma unroll
    for (int i = 0; i < 4; ++i) v[i] = __builtin_fabsf(v[i]) < 1e-6f ? __builtin_copysignf(1e-6f, v[i]) : v[i];
    return v; }
struct EpiRes {
    static constexpr bool PERM = true, AFTER_DRAIN = false, WANTS_NEXT = false;
    bf16_t* xn;
    const float* gate;
    const float* psc; const float* pg;
    const float* nsc; const float* ng;
    float* rss;
    PG8_LAS float* sv;
    __device__ __forceinline__ void operator()(const f32x4 (&acc)[2][2][4][2], const Unit& u, int wr, int wc, int fr, int fq) const {
        float ss[2][4];
#pragma unroll
        for (int ai = 0; ai < 2; ++ai)
#pragma unroll
            for (int m = 0; m < 4; ++m) ss[ai][m] = 0.f;
        const size_t so = (size_t)(u.pm >> 3) * (6 * DM);
        PG8_LAS float* sw = sv + (wr * 4 + wc) * 192 + fq * 8;
        {
            const int vb = fr >> 3, e = fr & 7, c = u.pn * BM + vb * HALF + wc * 32 + 8 * fq + e;
            float gp = pg[c] * (psc[so + c] + 1.0f); gp = __builtin_fabsf(gp) < 1e-6f ? __builtin_copysignf(1e-6f, gp) : gp;
            float gn = 1.0f; if (nsc) { gn = ng[c] * (nsc[so + c] + 1.0f); gn = __builtin_fabsf(gn) < 1e-6f ? __builtin_copysignf(1e-6f, gn) : gn; }
            sw[(vb * 3) * 32 + e] = gate[so + c]; sw[(vb * 3 + 1) * 32 + e] = 1.0f / gp; sw[(vb * 3 + 2) * 32 + e] = gn;
        }
#pragma unroll
        for (int bj = 0; bj < 2; ++bj) {
            const int c0 = u.pn * BM + bj * HALF + wc * 32 + 8 * fq;
            u32x4 xr[2][4];
#pragma unroll
            for (int ai = 0; ai < 2; ++ai)
#pragma unroll
                for (int m = 0; m < 4; ++m) xr[ai][m] = *(const u32x4*)(xn + (size_t)(u.pm * BM + ai * HALF + wr * 64 + m * 16 + fr) * DM + c0);
            asm volatile("s_waitcnt lgkmcnt(0)" ::: "memory");
#pragma unroll
            for (int ai = 0; ai < 2; ++ai)
#pragma unroll
                for (int m = 0; m < 4; ++m) {
                    const size_t ro = (size_t)(u.pm * BM + ai * HALF + wr * 64 + m * 16 + fr) * DM + c0;
                    f32x4 x0, x1; unpack8(xr[ai][m], x0, x1);
                    x0 = x0 * *(const PG8_LAS f32x4*)(sw + (bj * 3 + 1) * 32) + *(const PG8_LAS f32x4*)(sw + (bj * 3) * 32) * acc[ai][bj][m][0];
                    x1 = x1 * *(const PG8_LAS f32x4*)(sw + (bj * 3 + 1) * 32 + 4) + *(const PG8_LAS f32x4*)(sw + (bj * 3) * 32 + 4) * acc[ai][bj][m][1];
                    ss[ai][m] += ((x0[0] * x0[0] + x0[1] * x0[1]) + (x0[2] * x0[2] + x0[3] * x0[3])) + ((x1[0] * x1[0] + x1[1] * x1[1]) + (x1[2] * x1[2] + x1[3] * x1[3]));
                    *(u32x4*)(xn + ro) = pack8(x0 * *(const PG8_LAS f32x4*)(sw + (bj * 3 + 2) * 32), x1 * *(const PG8_LAS f32x4*)(sw + (bj * 3 + 2) * 32 + 4));
                    if (m == 3) asm volatile("" ::: "memory");
                }
        }
#pragma unroll
        for (int ai = 0; ai < 2; ++ai)
#pragma unroll
            for (int m = 0; m < 4; ++m) { float s = ss[ai][m]; s += __shfl_xor(s, 16); s += __shfl_xor(s, 32);
                if (fq == 0) rss[(size_t)(u.pm * BM + ai * HALF + wr * 64 + m * 16 + fr) * 16 + u.pn * 4 + wc] = s; }
    }
};

struct EpiGU {
    static constexpr bool PERM = true, AFTER_DRAIN = false, WANTS_NEXT = true;
    const float* rss; const float* bias;
    bf16_t* H;
    PG8_LAS float* st;
    __device__ __forceinline__ void fetch(const Unit& u, int wr, int wc, int fr, int fq, f32x4 (&pp)[2][4], f32x4 (&bb)[4]) const {
#pragma unroll
        for (int ai = 0; ai < 2; ++ai)
#pragma unroll
            for (int m = 0; m < 4; ++m) pp[ai][m] = *(const f32x4*)(rss + (size_t)(u.pm * BM + ai * HALF + wr * 64 + m * 16 + fr) * 16 + fq * 4);
        const float* bp = bias + (size_t)(u.pm >> 3) * NGU + u.pn * BM + wc * 32 + 8 * fq;
        bb[0] = *(const f32x4*)bp; bb[1] = *(const f32x4*)(bp + 4); bb[2] = *(const f32x4*)(bp + HALF); bb[3] = *(const f32x4*)(bp + HALF + 4);
    }
    __device__ __forceinline__ void park(int wr, int wc, int fr, int fq, const f32x4 (&pp)[2][4], const f32x4 (&bb)[4]) const {
        PG8_LAS float* sw = st + (wr * 4 + wc) * 192; float rs[2][4];
#pragma unroll
        for (int ai = 0; ai < 2; ++ai)
#pragma unroll
            for (int m = 0; m < 4; ++m) { const f32x4 p = pp[ai][m]; float s = (p[0] + p[1]) + (p[2] + p[3]); s += __shfl_xor(s, 16); s += __shfl_xor(s, 32); rs[ai][m] = rsqrtf(s * (1.0f / DM) + EPS); }
        if (fq == 0) { *(PG8_LAS f32x4*)(sw + fr * 8) = (f32x4){rs[0][0], rs[0][1], rs[0][2], rs[0][3]}; *(PG8_LAS f32x4*)(sw + fr * 8 + 4) = (f32x4){rs[1][0], rs[1][1], rs[1][2], rs[1][3]}; }
        if (fr == 0) {
#pragma unroll
            for (int q = 0; q < 4; ++q) *(PG8_LAS f32x4*)(sw + 128 + fq * 16 + 4 * q) = bb[q]; }
    }
    __device__ __forceinline__ void prime(const Unit& u, int wr, int wc, int fr, int fq) const { f32x4 pp[2][4], bb[4]; fetch(u, wr, wc, fr, fq, pp, bb); park(wr, wc, fr, fq, pp, bb); }
    __device__ __forceinline__ void operator()(const f32x4 (&acc)[2][2][4][2], const Unit& u, bool has_next, const Unit& nx, int wr, int wc, int fr, int fq) const {
        PG8_LAS float* sw = st + (wr * 4 + wc) * 192;
        const f32x4 r0 = *(const PG8_LAS f32x4*)(sw + fr * 8), r1 = *(const PG8_LAS f32x4*)(sw + fr * 8 + 4);
        const f32x4 ba0 = *(const PG8_LAS f32x4*)(sw + 128 + fq * 16), ba1 = *(const PG8_LAS f32x4*)(sw + 128 + fq * 16 + 4), bb0 = *(const PG8_LAS f32x4*)(sw + 128 + fq * 16 + 8), bb1 = *(const PG8_LAS f32x4*)(sw + 128 + fq * 16 + 12);
        f32x4 pp[2][4], nb[4];
        if (has_next) fetch(nx, wr, wc, fr, fq, pp, nb);
        const int hc = u.pn * HALF + wc * 32 + 8 * fq;
#pragma unroll
        for (int ai = 0; ai < 2; ++ai)
#pragma unroll
            for (int m = 0; m < 4; ++m) {
                const int row = u.pm * BM + ai * HALF + wr * 64 + m * 16 + fr; const float r = ai ? r1[m] : r0[m];
                const f32x4 a0 = acc[ai][0][m][0] * r + ba0, a1 = acc[ai][0][m][1] * r + ba1, b0 = acc[ai][1][m][0] * r + bb0, b1 = acc[ai][1][m][1] * r + bb1;
                f32x4 h0, h1;
#pragma unroll
                for (int i = 0; i < 4; ++i) { h0[i] = a0[i] * b0[i] * __builtin_amdgcn_rcpf(1.0f + __builtin_amdgcn_exp2f(-LOG2E * a0[i])); h1[i] = a1[i] * b1[i] * __builtin_amdgcn_rcpf(1.0f + __builtin_amdgcn_exp2f(-LOG2E * a1[i])); }
                *(u32x4*)(H + (size_t)row * DFF + hc) = pack8(h0, h1);
            }
        if (has_next) park(wr, wc, fr, fq, pp, nb);
    }
};

template <class Epi, class Sched, bool ALIGN_EPI = false, bool SP2 = false>
__device__ __forceinline__ void gemm_phase(PG8_LAS unsigned char* lds, const Gemm g, const Sched& S, const Epi& E, int tid_in) {
    int tid = tid_in; asm volatile("" : "+v"(tid));
    const int wid = __builtin_amdgcn_readfirstlane(tid >> 6), lane = tid & 63, wr = wid >> 2, wc = wid & 3, fr = lane & 15, fq = lane >> 4;
    const int K = g.K, nt = K / BK;
    unsigned voffA[2], voffB[2];
#pragma unroll
    for (int i = 0; i < 2; ++i) { int R, C; stage_rc(tid * 16 + i * 8192, R, C); const int Rb = Epi::PERM ? ((R & ~31) + perm32(R & 31)) : R;
        voffA[i] = (unsigned)(R * K + C) * 2u; voffB[i] = (unsigned)(Rb * K + C) * 2u; }
    const size_t kstep = (size_t)(BK * 2);
    const size_t hstep = (size_t)HALF * K * 2;
    const size_t tstep = 2 * hstep;
    const unsigned ldsw = (unsigned)wid * 1024u;
    const int aoff = lds_byte(wr * 64 + fr, fq * 8), boff = lds_byte(wc * 32 + fr, fq * 8);
#define PG8_SA(b, h) (((b) * 2 + (h)) * HTB)
#define PG8_SB(b, h) ((4 + (b) * 2 + (h)) * HTB)
#define PG8_STAGE(bufoff, gbase, voff) do { _Pragma("unroll") for (int _i = 0; _i < 2; ++_i) \
        __builtin_amdgcn_global_load_lds((const unsigned*)((const char*)(gbase) + (voff)[_i]), (PG8_LAS unsigned*)(lds + (bufoff) + ldsw + _i * 8192), 16, 0, 0); } while (0)
#define PG8_LDA(dst, b, h) do { _Pragma("unroll") for (int m = 0; m < 4; ++m) _Pragma("unroll") for (int k = 0; k < 2; ++k) dst[m][k] = *(const PG8_LAS bf16x8*)(lds + PG8_SA(b, h) + aoff + m * 2048 + k * 1024); } while (0)
#define PG8_LDB(dst, b, h) do { _Pragma("unroll") for (int n = 0; n < 2; ++n) _Pragma("unroll") for (int k = 0; k < 2; ++k) dst[n][k] = *(const PG8_LAS bf16x8*)(lds + PG8_SB(b, h) + boff + n * 2048 + k * 1024); } while (0)
#define PG8_MMA(ai, bj, At, Bt) do { __builtin_amdgcn_s_setprio(1); _Pragma("unroll") for (int m = 0; m < 4; ++m) _Pragma("unroll") for (int n = 0; n < 2; ++n) _Pragma("unroll") for (int k = 0; k < 2; ++k) \
        acc[ai][bj][m][n] = __builtin_amdgcn_mfma_f32_16x16x32_bf16(Bt[n][k], At[m][k], acc[ai][bj][m][n], 0, 0, 0); __builtin_amdgcn_s_setprio(0); } while (0)
#define PG8_WAIT_V(n) asm volatile("s_waitcnt vmcnt(" #n ")" ::: "memory")
#define PG8_WAIT_L(n) asm volatile("s_waitcnt lgkmcnt(" #n ")" ::: "memory")
#define PG8_BAR __builtin_amdgcn_s_barrier()
#define PG8_SCHED __builtin_amdgcn_sched_barrier(0)
    Unit cur, nxt; int ui = 0;
    if (!S.next(0, cur)) return;
    if constexpr (Epi::WANTS_NEXT) E.prime(cur, wr, wc, fr, fq);
    f32x4 acc[2][2][4][2];
#pragma unroll
    for (int a = 0; a < 2; ++a)
#pragma unroll
        for (int b = 0; b < 2; ++b)
#pragma unroll
            for (int m = 0; m < 4; ++m)
#pragma unroll
                for (int n = 0; n < 2; ++n) acc[a][b][m][n] = (f32x4){0.f, 0.f, 0.f, 0.f};
    bf16x8 At[4][2], B0[2][2], B1[2][2];
    const char* cA = (const char*)g.A + (size_t)cur.pm * tstep; const char* cB = (const char*)g.Bt + (size_t)cur.pn * tstep;
    S.a_ready(cur);
    if constexpr (SP2) {
        PG8_STAGE(PG8_SB(0, 0), cB, voffB); PG8_STAGE(PG8_SB(0, 1), cB + hstep, voffB); PG8_STAGE(PG8_SA(0, 0), cA, voffA); PG8_STAGE(PG8_SA(0, 1), cA + hstep, voffA);
        if (wr == 1) PG8_BAR;
        PG8_WAIT_V(2); PG8_BAR;
        PG8_STAGE(PG8_SB(1, 0), cB + kstep, voffB); PG8_STAGE(PG8_SA(1, 0), cA + kstep, voffA); PG8_STAGE(PG8_SB(1, 1), cB + hstep + kstep, voffB);
        PG8_WAIT_V(6); PG8_BAR;
    } else {
        PG8_STAGE(PG8_SB(0, 0), cB, voffB); PG8_STAGE(PG8_SA(0, 0), cA, voffA); PG8_STAGE(PG8_SB(0, 1), cB + hstep, voffB); PG8_STAGE(PG8_SA(0, 1), cA + hstep, voffA);
        if (wr == 1) PG8_BAR;
        PG8_WAIT_V(4); PG8_BAR;
        PG8_STAGE(PG8_SB(1, 0), cB + kstep, voffB); PG8_STAGE(PG8_SA(1, 0), cA + kstep, voffA); PG8_STAGE(PG8_SB(1, 1), cB + hstep + kstep, voffB);
        PG8_WAIT_V(6); PG8_BAR;
    }
    for (;;) {
        const bool has_next = S.next(ui + 1, nxt);
        const char* nA = has_next ? (const char*)g.A + (size_t)nxt.pm * tstep : cA; const char* nB = has_next ? (const char*)g.Bt + (size_t)nxt.pn * tstep : cB;
        for (int t = 0; t < nt; t += 2) {
            const bool last = (t == nt - 2);
            const char* a1 = cA + (size_t)(t + 1) * kstep;
            const char* a2 = last ? nA : cA + (size_t)(t + 2) * kstep; const char* b2 = last ? nB : cB + (size_t)(t + 2) * kstep;
            const char* a3 = a2 + kstep; const char* b3 = b2 + kstep;
            if (last && has_next) S.a_ready(nxt);
            if constexpr (SP2) {
            PG8_LDB(B0, 0, 0); PG8_LDB(B1, 0, 1); PG8_SCHED; PG8_LDA(At, 0, 0); PG8_STAGE(PG8_SA(1, 1), a1 + hstep, voffA);
            PG8_WAIT_V(8); PG8_WAIT_L(0); PG8_BAR; PG8_MMA(0, 0, At, B0); PG8_MMA(0, 1, At, B1); PG8_BAR; PG8_SCHED;
            PG8_LDA(At, 0, 1); PG8_STAGE(PG8_SB(0, 0), b2, voffB); PG8_STAGE(PG8_SB(0, 1), b2 + hstep, voffB); PG8_STAGE(PG8_SA(0, 0), a2, voffA);
            PG8_WAIT_V(8); PG8_WAIT_L(0); PG8_BAR; PG8_MMA(1, 0, At, B0); PG8_MMA(1, 1, At, B1); PG8_BAR; PG8_SCHED;
            PG8_LDB(B0, 1, 0); PG8_LDB(B1, 1, 1); PG8_SCHED; PG8_LDA(At, 1, 0); PG8_STAGE(PG8_SA(0, 1), a2 + hstep, voffA);
            PG8_WAIT_V(8); PG8_WAIT_L(0); PG8_BAR; PG8_MMA(0, 0, At, B0); PG8_MMA(0, 1, At, B1); PG8_BAR; PG8_SCHED;
            PG8_LDA(At, 1, 1); PG8_STAGE(PG8_SB(1, 0), b3, voffB); PG8_STAGE(PG8_SB(1, 1), b3 + hstep, voffB); PG8_STAGE(PG8_SA(1, 0), a3, voffA);
            PG8_WAIT_V(8); PG8_WAIT_L(0); PG8_BAR; PG8_MMA(1, 0, At, B0); PG8_MMA(1, 1, At, B1); PG8_BAR; PG8_SCHED;
            } else {
            PG8_LDB(B0, 0, 0); PG8_SCHED; PG8_LDA(At, 0, 0); PG8_STAGE(PG8_SA(1, 1), a1 + hstep, voffA);
            PG8_WAIT_L(8); PG8_BAR; PG8_WAIT_L(0); PG8_MMA(0, 0, At, B0); PG8_BAR; PG8_SCHED;
            PG8_LDB(B1, 0, 1); PG8_STAGE(PG8_SB(0, 0), b2, voffB);
            PG8_BAR; PG8_WAIT_L(0); PG8_MMA(0, 1, At, B1); PG8_BAR;
            PG8_LDA(At, 0, 1); PG8_STAGE(PG8_SA(0, 0), a2, voffA);
            PG8_BAR; PG8_WAIT_L(0); PG8_MMA(1, 0, At, B0); PG8_BAR; PG8_SCHED;
            PG8_STAGE(PG8_SB(0, 1), b2 + hstep, voffB);
            PG8_WAIT_V(6); PG8_BAR; PG8_MMA(1, 1, At, B1); PG8_BAR;
            PG8_LDB(B0, 1, 0); PG8_SCHED; PG8_LDA(At, 1, 0); PG8_STAGE(PG8_SA(0, 1), a2 + hstep, voffA);
            PG8_WAIT_L(8); PG8_BAR; PG8_WAIT_L(0); PG8_MMA(0, 0, At, B0); PG8_BAR; PG8_SCHED;
            PG8_LDB(B1, 1, 1); PG8_STAGE(PG8_SB(1, 0), b3, voffB);
            PG8_BAR; PG8_WAIT_L(0); PG8_MMA(0, 1, At, B1); PG8_BAR;
            PG8_LDA(At, 1, 1); PG8_STAGE(PG8_SA(1, 0), a3, voffA);
            PG8_BAR; PG8_WAIT_L(0); PG8_MMA(1, 0, At, B0); PG8_BAR; PG8_SCHED;
            PG8_STAGE(PG8_SB(1, 1), b3 + hstep, voffB);
            PG8_WAIT_V(6); PG8_BAR; PG8_MMA(1, 1, At, B1); PG8_BAR;
            }
        }
        if constexpr (ALIGN_EPI) { if (wr == 0) PG8_BAR; }
        if constexpr (!Epi::AFTER_DRAIN) { if constexpr (Epi::WANTS_NEXT) E(acc, cur, has_next, nxt, wr, wc, fr, fq); else E(acc, cur, wr, wc, fr, fq); S.done(cur); }
        if (!has_next) break;
#pragma unroll
        for (int a = 0; a < 2; ++a)
#pragma unroll
            for (int b = 0; b < 2; ++b)
#pragma unroll
                for (int m = 0; m < 4; ++m)
#pragma unroll
                    for (int n = 0; n < 2; ++n) acc[a][b][m][n] = (f32x4){0.f, 0.f, 0.f, 0.f};
        cur = nxt; cA = nA; cB = nB; ++ui;
        if constexpr (ALIGN_EPI) { if (wr == 1) PG8_BAR; }
    }
    PG8_WAIT_V(0);
    if constexpr (!ALIGN_EPI) { if (wr == 0) PG8_BAR; }
    PG8_BAR;
    if constexpr (Epi::AFTER_DRAIN) { E.fused(acc, cur, wr, wc, fr, fq, lds, wid, lane); S.done(cur); }
#undef PG8_SA
#undef PG8_SB
#undef PG8_STAGE
#undef PG8_LDA
#undef PG8_LDB
#undef PG8_MMA
#undef PG8_WAIT_V
#undef PG8_WAIT_L
#undef PG8_BAR
#undef PG8_SCHED
}
}

#define LAS __attribute__((address_space(3)))
#define XB_TMO      128
#define XB_XCNT(j)  (256  + 64 * (j))
#define XB_XSUB(j)  (1280 + 64 * (j))
#define XB_XGEN(j)  (2304 + 64 * (j))
#define XB_TOP      3328
#define XB_TOPGEN   3392
#define XCD_BAR_WORDS 3456
#define XB_SPIN_CAP (1u << 18)

__device__ __forceinline__ unsigned xb_ld(unsigned* p)              { return __hip_atomic_load(p, __ATOMIC_RELAXED, __HIP_MEMORY_SCOPE_AGENT); }
__device__ __forceinline__ unsigned xb_add(unsigned* p, unsigned v) { return __hip_atomic_fetch_add(p, v, __ATOMIC_RELAXED, __HIP_MEMORY_SCOPE_AGENT); }
__device__ __forceinline__ unsigned xb_xcc_id() { return (unsigned)__builtin_amdgcn_s_getreg((3 << 11) | 20) & 0xFu; }
#define XB_SPIN(cond, bar) do { unsigned _sp = 0; while (cond) { __builtin_amdgcn_s_sleep(1); \
    if ((++_sp & 255u) == 0u) { if (xb_ld(&(bar)[XB_TMO])) break; if (_sp > XB_SPIN_CAP) { atomicAdd(&(bar)[XB_TMO], 1u); break; } } } } while (0)

struct XcdBarrier {
    unsigned* bar; unsigned x;
    volatile LAS unsigned* st;
};

__device__ __forceinline__ XcdBarrier xcd_barrier_post(unsigned* bar, volatile LAS unsigned* st) {
    XcdBarrier b; b.bar = bar; b.x = xb_xcc_id(); b.st = st;
    if (threadIdx.x == 0) (void)xb_add(&bar[XB_XCNT(b.x)], 1u);
    return b;
}
__device__ __forceinline__ void xcd_barrier_complete(unsigned* bar, unsigned x, unsigned& nloc, unsigned& nx) {
    const unsigned G = gridDim.x * gridDim.y * gridDim.z;
    unsigned sum, cnt, mine, sp = 0u;
    for (;;) {
        sum = 0u; cnt = 0u; mine = 0u;
#pragma unroll
        for (unsigned j = 0; j < 16; ++j) { const unsigned c = xb_ld(&bar[XB_XCNT(j)]); sum += c; cnt += (c > 0u) ? 1u : 0u; mine = (j == x) ? c : mine; }
        if (sum == G) break;
        __builtin_amdgcn_s_sleep(1);
        if ((++sp & 255u) == 0u) { if (xb_ld(&bar[XB_TMO])) break; if (sp > XB_SPIN_CAP) { atomicAdd(&bar[XB_TMO], 1u); break; } }
    }
    nloc = mine > 0u ? mine : 1u; nx = cnt > 0u ? cnt : 1u;
}

__device__ __forceinline__ void xcd_barrier(const XcdBarrier& b) {
    asm volatile("s_waitcnt vmcnt(0)" ::: "memory");
    __syncthreads();
    if (threadIdx.x == 0) {
        unsigned* bar = b.bar;
        __builtin_amdgcn_s_waitcnt(0);
        unsigned nloc = b.st[0], nx = b.st[1];
        if (nloc == 0u) { xcd_barrier_complete(bar, b.x, nloc, nx); b.st[0] = nloc; b.st[1] = nx; }
        const unsigned old = xb_add(&bar[XB_XSUB(b.x)], 1u);
        const unsigned gen = old / nloc;
        if (old + 1u == (gen + 1u) * nloc) {
            __builtin_amdgcn_fence(__ATOMIC_RELEASE, "agent");
            asm volatile("s_waitcnt vmcnt(0)" ::: "memory");
            const unsigned og = xb_add(&bar[XB_TOP], 1u);
            const unsigned tg = og / nx;
            if (og + 1u == (tg + 1u) * nx) xb_add(&bar[XB_TOPGEN], 1u);
            else XB_SPIN(xb_ld(&bar[XB_TOPGEN]) == tg, bar);
            __builtin_amdgcn_fence(__ATOMIC_ACQUIRE, "agent");
            xb_add(&bar[XB_XGEN(b.x)], 1u);
            asm volatile("s_waitcnt vmcnt(0)" ::: "memory");
        } else {
            XB_SPIN(xb_ld(&bar[XB_XGEN(b.x)]) == gen, bar);
            __builtin_amdgcn_fence(__ATOMIC_ACQUIRE, "agent");
            asm volatile("s_waitcnt vmcnt(0)" ::: "memory");
        }
    }
    __syncthreads();
}


typedef unsigned short bf16;
typedef unsigned u32x4 __attribute__((ext_vector_type(4)));
typedef unsigned u32x2 __attribute__((ext_vector_type(2)));
typedef float f32x4 __attribute__((ext_vector_type(4)));
typedef float f32x16 __attribute__((ext_vector_type(16)));
typedef short bf16x8 __attribute__((ext_vector_type(8)));
typedef short s16x4 __attribute__((ext_vector_type(4)));
using pg8::cvtpk; using pg8::pack8;

struct Args {
    const float *x_prompt, *x_sample, *cache_pool, *cache_k, *cache_v, *c_prompt, *c_sample, *w_ada, *b_ada, *g_mix, *w_in, *pool_w, *pool_scale, *sinks, *w_out, *g_ffn, *w_gate_up, *w_down, *g_final;
    float* out; unsigned char* ws;
};

__device__ __forceinline__ float wave_sum(float v) {
#pragma unroll
    for (int o = 1; o < 64; o <<= 1) v += __shfl_xor(v, o);
    return v;
}
__device__ __forceinline__ int crow(int r, int hi) { return (r & 3) + 8 * (r >> 2) + 4 * hi; }
__device__ __forceinline__ float bf_lo(unsigned w) { return __uint_as_float(w << 16); }
__device__ __forceinline__ float bf_hi(unsigned w) { return __uint_as_float(w & 0xffff0000u); }
__device__ __forceinline__ float silu_f(float v) { return v * __builtin_amdgcn_rcpf(1.0f + __builtin_amdgcn_exp2f(-LOG2E * v)); }

__device__ __forceinline__ void transpose_item(const float* W, int ldw, bf16* WT, int ldt, int out_row0, int out_col0, LAS float* scr, int lane) {
    f32x4 v[16];
#pragma unroll
    for (int i = 0; i < 16; ++i) v[i] = *(const f32x4*)(W + (size_t)(4 * i + (lane >> 4)) * ldw + 4 * (lane & 15));
    const int c = lane & 7;
#pragma unroll
    for (int p = 0; p < 2; ++p) {
        if (((lane & 15) >> 3) == p) {
#pragma unroll
            for (int i = 0; i < 16; ++i) { LAS float* s = scr + (4 * i + (lane >> 4)) * 33 + 4 * (lane & 7); s[0] = v[i][0]; s[1] = v[i][1]; s[2] = v[i][2]; s[3] = v[i][3]; } }
        asm volatile("s_waitcnt lgkmcnt(0)" ::: "memory");
#pragma unroll
        for (int j = 0; j < 4; ++j) { const int n = (lane >> 3) + 8 * j; const LAS float* s = scr + (8 * c) * 33 + n;
            u32x4 o; o.x = cvtpk(s[0 * 33], s[1 * 33]); o.y = cvtpk(s[2 * 33], s[3 * 33]); o.z = cvtpk(s[4 * 33], s[5 * 33]); o.w = cvtpk(s[6 * 33], s[7 * 33]);
            *(u32x4*)(WT + (size_t)(out_row0 + 32 * p + n) * ldt + out_col0 + 8 * c) = o; }
        asm volatile("s_waitcnt lgkmcnt(0)" ::: "memory");
    }
}
__device__ __forceinline__ int grab(LAS unsigned* ctr, int lane) { unsigned v = 0u; if (lane == 0) v = __hip_atomic_fetch_add(ctr, 1u, __ATOMIC_RELAXED, __HIP_MEMORY_SCOPE_WORKGROUP); return (int)__builtin_amdgcn_readfirstlane(v) * (int)gridDim.x + (int)blockIdx.x; }

#define MFMA_BF(a, b, c) __builtin_amdgcn_mfma_f32_32x32x16_bf16((a), (b), (c), 0, 0, 0)
#define MFMA_F32(a, b, c) __builtin_amdgcn_mfma_f32_32x32x2f32((a), (b), (c), 0, 0, 0)
template <class LA, class LB>
__device__ __forceinline__ void sgemm64_1(int kb, int ke, const LA& la, const LB& lb, f32x16& c0, f32x16& c1, int lane) {
    const int r = lane & 31, h = lane >> 5;
#pragma unroll
    for (int i = 0; i < 16; ++i) { c0[i] = 0.f; c1[i] = 0.f; }
    f32x4 a0[4], a1[4], p0[4], p1[4]; float b[4][4], q[4][4];
#define SG_LOAD(A0, A1, B, kk) do { _Pragma("unroll") for (int u = 0; u < 4; ++u) { const int k = (kk) + 8 * u + 4 * h; A0[u] = la(0, r, k); A1[u] = la(1, r, k); _Pragma("unroll") for (int j = 0; j < 4; ++j) B[u][j] = lb(k + j, r); } } while (0)
#define SG_MMA(A0, A1, B) do { _Pragma("unroll") for (int u = 0; u < 4; ++u) _Pragma("unroll") for (int j = 0; j < 4; ++j) { c0 = MFMA_F32(A0[u][j], B[u][j], c0); c1 = MFMA_F32(A1[u][j], B[u][j], c1); } } while (0)
    SG_LOAD(a0, a1, b, kb);
    for (int k0 = kb; k0 < ke; k0 += 64) {
        SG_LOAD(p0, p1, q, k0 + 32);
        SG_MMA(a0, a1, b);
        if (k0 + 64 < ke) SG_LOAD(a0, a1, b, k0 + 64);
        SG_MMA(p0, p1, q);
    }
#undef SG_LOAD
#undef SG_MMA
}
template <int NB, class LA, class LB>
__device__ __forceinline__ void sgemm64(int kb, int ke, const LA& la, const LB& lb, f32x16 (&c)[NB][2], int lane) {
    constexpr int SUB = NB == 1 ? 4 : 2;
    const int r = lane & 31, h = lane >> 5;
#pragma unroll
    for (int nb = 0; nb < NB; ++nb)
#pragma unroll
        for (int i = 0; i < 16; ++i) { c[nb][0][i] = 0.f; c[nb][1][i] = 0.f; }
    f32x4 a0[SUB], a1[SUB], p0[SUB], p1[SUB]; float b[NB][SUB][4], q[NB][SUB][4];
#define SG_LOAD(A0, A1, B, kk) do { _Pragma("unroll") for (int u = 0; u < SUB; ++u) { const int k = (kk) + 8 * u + 4 * h; A0[u] = la(0, r, k); A1[u] = la(1, r, k); _Pragma("unroll") for (int nb = 0; nb < NB; ++nb) _Pragma("unroll") for (int j = 0; j < 4; ++j) B[nb][u][j] = lb(k + j, r + 32 * nb); } } while (0)
#define SG_MMA(A0, A1, B) do { _Pragma("unroll") for (int u = 0; u < SUB; ++u) _Pragma("unroll") for (int j = 0; j < 4; ++j) _Pragma("unroll") for (int nb = 0; nb < NB; ++nb) { c[nb][0] = MFMA_F32(A0[u][j], B[nb][u][j], c[nb][0]); c[nb][1] = MFMA_F32(A1[u][j], B[nb][u][j], c[nb][1]); } } while (0)
    SG_LOAD(a0, a1, b, kb);
    for (int k0 = kb; k0 < ke; k0 += 16 * SUB) {
        SG_LOAD(p0, p1, q, k0 + 8 * SUB);
        SG_MMA(a0, a1, b);
        if (k0 + 16 * SUB < ke) SG_LOAD(a0, a1, b, k0 + 16 * SUB);
        SG_MMA(p0, p1, q);
    }
#undef SG_LOAD
#undef SG_MMA
}
template <class LA, class LB>
__device__ __forceinline__ void wg_sgemm64x2(LAS unsigned char* lds, int K, const LA& la, const LB& lb, float* out, int ld, const float* addp, int lane, int wave) {
    f32x16 c[2][2]; sgemm64<2>(wave * (K >> 3), (wave + 1) * (K >> 3), la, lb, c, lane);
    LAS float* red = (LAS float*)lds;
#pragma unroll
    for (int nb = 0; nb < 2; ++nb)
#pragma unroll
        for (int blk = 0; blk < 2; ++blk)
#pragma unroll
            for (int i = 0; i < 16; ++i) red[(wave * 64 + nb * 32 + blk * 16 + i) * 64 + lane] = c[nb][blk][i];
    __syncthreads();
    const int h = lane >> 5;
#pragma unroll
    for (int j = 0; j < 8; ++j) { const int i = 8 * wave + j, nb = i >> 5, blk = (i >> 4) & 1, reg = i & 15; float s = 0.f;
#pragma unroll
        for (int p = 0; p < 8; ++p) s += red[(p * 64 + i) * 64 + lane];
        const int col = 32 * nb + (lane & 31); out[(size_t)(32 * blk + crow(reg, h)) * ld + col] = s + (addp ? addp[col] : 0.f); }
    __syncthreads();
}
struct LA_silu { const float* cp; const float* cs; __device__ __forceinline__ f32x4 operator()(int blk, int r, int k) const { const f32x4 v = *(const f32x4*)((blk ? cs : cp) + (size_t)r * DM + k); return (f32x4){silu_f(v[0]), silu_f(v[1]), silu_f(v[2]), silu_f(v[3])}; } };
struct LA_rows { const float* A; int lda; __device__ __forceinline__ f32x4 operator()(int blk, int r, int k) const { return *(const f32x4*)(A + (size_t)(32 * blk + r) * lda + k); } };
struct LB_plain { const float* B; int ldb; __device__ __forceinline__ float operator()(int k, int r) const { return B[(size_t)k * ldb + r]; } };
struct LB_scaled { const float* B; int ldb; const float* s; __device__ __forceinline__ float operator()(int k, int r) const { return B[(size_t)k * ldb + r] * s[k]; } };

__device__ __forceinline__ void phase0a(const Args& a, LAS unsigned char* lds, int tid, int lane, int wave, int cw = 16) {
    const int gw = blockIdx.x * 8 + wave, NGW = gridDim.x * 8, r = lane & 31, h = lane >> 5;
    LAS float* scr = (LAS float*)(lds + wave * 16384);
    float* mod = (float*)(a.ws + WS_MOD);
    bf16 *WinT = (bf16*)(a.ws + WS_WIN), *WoT = (bf16*)(a.ws + WS_WO), *WguT = (bf16*)(a.ws + WS_WGU), *WdT = (bf16*)(a.ws + WS_WD);
    constexpr int I_MOD = DEPTH * (6 * DM / 64), I_FOLD = DEPTH * 4 * 2 * (DM / 32);
    constexpr int T_IN = (DM / 64) * (INW / 64), T_OB = (512 / 64) * (DM / 64), T_GU = (DM / 64) * (NGU / 64), T_D = (DFF / 64) * (DM / 64), T_L = T_IN + T_OB + T_GU + T_D;
    constexpr int NITEMS = I_MOD + I_FOLD + DEPTH * T_L;
    for (int q = blockIdx.x; q < I_MOD; q += gridDim.x) {
        const int l = q / (6 * DM / 64), n0 = (q % (6 * DM / 64)) * 64;
        wg_sgemm64x2(lds, DM, LA_silu{a.c_prompt, a.c_sample}, LB_plain{a.w_ada + (size_t)l * DM * 6 * DM + n0, 6 * DM}, mod + (size_t)l * NSEQ * 6 * DM + n0, 6 * DM, a.b_ada + l * 6 * DM + n0, lane, wave);
    }
    LAS unsigned* ctr = (LAS unsigned*)(lds + XB_LDS_OFF) + cw;
    for (int it = grab(ctr, lane); it < NITEMS - I_MOD; it = grab(ctr, lane)) {
        int q = it; int ln = lane; asm volatile("" : "+v"(ln));
        if (q < I_FOLD) {
            const int nb = q % (DM / 32), half = (q / (DM / 32)) & 1, g = (q / (2 * DM / 32)) & 3, l = q / (8 * DM / 32), n0 = nb * 32;
            f32x16 c0, c1; sgemm64_1(0, 128, LA_rows{a.pool_w + ((size_t)(l * 4 + g) * 128 + half * 64) * 128, 128}, LB_scaled{a.w_out + ((size_t)l * DM + g * 128) * DM + n0, DM, a.pool_scale + l * PW + g * 128}, c0, c1, lane);
            bf16* wo = WoT + ((size_t)l * DM + n0 + r) * DM + g * 128 + half * 64 + 4 * h;
#pragma unroll
            for (int ig = 0; ig < 4; ++ig) { u32x2 w0, w1; w0.x = cvtpk(c0[4 * ig], c0[4 * ig + 1]); w0.y = cvtpk(c0[4 * ig + 2], c0[4 * ig + 3]); w1.x = cvtpk(c1[4 * ig], c1[4 * ig + 1]); w1.y = cvtpk(c1[4 * ig + 2], c1[4 * ig + 3]);
                *(u32x2*)(wo + 8 * ig) = w0; *(u32x2*)(wo + 32 + 8 * ig) = w1; }
            continue; }
        q -= I_FOLD;
        const int l = q / T_L; q -= l * T_L;
        if (q < T_IN) { const int kb = q / (INW / 64), nb = q % (INW / 64); transpose_item(a.w_in + ((size_t)l * DM + 64 * kb) * INW + 64 * nb, INW, WinT + (size_t)l * INW * DM, DM, 64 * nb, 64 * kb, scr, ln); continue; }
        q -= T_IN;
        if (q < T_OB) { const int kb = q / (DM / 64), nb = q % (DM / 64); transpose_item(a.w_out + ((size_t)l * DM + 512 + 64 * kb) * DM + 64 * nb, DM, WoT + (size_t)l * DM * DM, DM, 64 * nb, 512 + 64 * kb, scr, ln); continue; }
        q -= T_OB;
        if (q < T_GU) { const int kb = q / (NGU / 64), nb = q % (NGU / 64), o = 64 * nb, bj = o / DFF, rem = o - bj * DFF, orow = (rem >> 7) * 256 + bj * 128 + (rem & 127);
            transpose_item(a.w_gate_up + ((size_t)l * DM + 64 * kb) * NGU + o, NGU, WguT + (size_t)l * NGU * DM, DM, orow, 64 * kb, scr, ln); continue; }
        q -= T_GU;
        { const int kb = q / (DM / 64), nb = q % (DM / 64); transpose_item(a.w_down + ((size_t)l * DFF + 64 * kb) * DM + 64 * nb, DM, WdT + (size_t)l * DM * DFF, DFF, 64 * nb, 64 * kb, scr, ln); }
    }
    constexpr int CP4 = (WIN - DSEQ) * KVW / 4, NCP = DEPTH * 32 * 2 * CP4;
    for (int i = blockIdx.x * 512 + tid; i < NCP; i += gridDim.x * 512) {
        const int e = i % CP4, lb2 = i / CP4, kv = lb2 & 1, lb = lb2 >> 1;
        const f32x4 v = *(const f32x4*)((kv ? a.cache_v : a.cache_k) + ((size_t)lb * WIN + DSEQ) * KVW + 4 * e);
        *(f32x4*)(a.out + (kv ? O_VS : O_KS) + (size_t)lb * WIN * KVW + 4 * e) = v;
    }
}

__device__ __forceinline__ void phase0b(const Args& a, LAS unsigned char* lds, int tid, int lane, int wave, int cw = 17) {
    const int gw = blockIdx.x * 8 + wave, NGW = gridDim.x * 8, r = lane & 31, h = lane >> 5;
    const float* mod = (const float*)(a.ws + WS_MOD);
    float *bin = (float*)(a.ws + WS_BIN), *bgu = (float*)(a.ws + WS_BGU);
    constexpr int I_BIN = DEPTH * (INW / 32), I_BGU = DEPTH * (NGU / 32);
    bf16* XN = (bf16*)(a.ws + WS_XN); float* rss = (float*)(a.ws + WS_RSS);
    LAS unsigned* ctr = (LAS unsigned*)(lds + XB_LDS_OFF) + cw;
    constexpr int RCH = 8, I_ROWS = MT / RCH;
    for (int it = grab(ctr, lane); it < I_BIN + I_BGU + I_ROWS; it = grab(ctr, lane)) {
        if (it < I_BIN + I_BGU) {
            const bool gu = it >= I_BIN; const int q = gu ? it - I_BIN : it, NW = gu ? NGU : INW, l = q / (NW / 32), n0 = (q % (NW / 32)) * 32;
            const bf16* wp = (const bf16*)(a.ws + (gu ? WS_WGU : WS_WIN)) + ((size_t)l * NW + n0 + r) * DM + 8 * h;
            const float* sp = mod + ((size_t)l * NSEQ + r) * 6 * DM + (gu ? 3 * DM : 0) + 8 * h;
            f32x16 c0, c1;
#pragma unroll
            for (int i = 0; i < 16; ++i) { c0[i] = 0.f; c1[i] = 0.f; }
#pragma unroll 4
            for (int kk = 0; kk < DM; kk += 16) {
                const bf16x8 w = *(const bf16x8*)(wp + kk);
#pragma unroll
                for (int blk = 0; blk < 2; ++blk) { const float* s = sp + (size_t)blk * 32 * 6 * DM + kk; const f32x4 s0 = *(const f32x4*)s, s1 = *(const f32x4*)(s + 4);
                    const u32x4 hi = pack8(s0, s1); f32x4 h0, h1; pg8::unpack8(hi, h0, h1); const u32x4 lo = pack8(s0 - h0, s1 - h1);
                    if (blk == 0) { c0 = MFMA_BF(w, __builtin_bit_cast(bf16x8, hi), c0); c0 = MFMA_BF(w, __builtin_bit_cast(bf16x8, lo), c0); }
                    else { c1 = MFMA_BF(w, __builtin_bit_cast(bf16x8, hi), c1); c1 = MFMA_BF(w, __builtin_bit_cast(bf16x8, lo), c1); } }
            }
            float* ob = (gu ? bgu : bin) + ((size_t)l * NSEQ + r) * NW + n0 + 4 * h;
#pragma unroll
            for (int ig = 0; ig < 4; ++ig) { *(f32x4*)(ob + 8 * ig) = (f32x4){c0[4 * ig], c0[4 * ig + 1], c0[4 * ig + 2], c0[4 * ig + 3]}; *(f32x4*)(ob + (size_t)32 * NW + 8 * ig) = (f32x4){c1[4 * ig], c1[4 * ig + 1], c1[4 * ig + 2], c1[4 * ig + 3]}; }
            continue;
        }
        {
            const int row0 = (it - I_BIN - I_BGU) * RCH;
            f32x4 gm[4];
#pragma unroll
            for (int j = 0; j < 4; ++j) gm[j] = *(const f32x4*)(a.g_mix + 4 * (lane + 64 * j));
#pragma unroll
            for (int rb = 0; rb < RCH; rb += 4) {
                f32x4 v[4][4];
#pragma unroll
                for (int rr = 0; rr < 4; ++rr) { const int row = row0 + rb + rr; const float* xr = row < MP ? a.x_prompt + (size_t)row * DM : a.x_sample + (size_t)(row - MP) * DM;
#pragma unroll
                    for (int j = 0; j < 4; ++j) v[rr][j] = *(const f32x4*)(xr + 4 * (lane + 64 * j)); }
#pragma unroll
                for (int rr = 0; rr < 4; ++rr) { const int row = row0 + rb + rr; const float* sc = mod + (size_t)pg8::row_seq(row) * 6 * DM + DM; float s = 0.f;
#pragma unroll
                    for (int j = 0; j < 4; ++j) s += (v[rr][j][0] * v[rr][j][0] + v[rr][j][1] * v[rr][j][1]) + (v[rr][j][2] * v[rr][j][2] + v[rr][j][3] * v[rr][j][3]);
                    s = wave_sum(s);
#pragma unroll
                    for (int j = 0; j < 4; ++j) { const int c = 4 * (lane + 64 * j); const f32x4 o = v[rr][j] * pg8::gm4(gm[j], *(const f32x4*)(sc + c));
                        u32x2 w; w.x = cvtpk(o[0], o[1]); w.y = cvtpk(o[2], o[3]); *(u32x2*)(XN + (size_t)row * DM + c) = w;
                    }
                    if (lane < 16) rss[(size_t)row * 16 + lane] = lane == 0 ? s : 0.f; }
            }
        }
    }
}

__device__ __forceinline__ void ld8(float (&o)[8], const bf16* p) { const u32x4 w = *(const u32x4*)p; o[0] = bf_lo(w.x); o[1] = bf_hi(w.x); o[2] = bf_lo(w.y); o[3] = bf_hi(w.y); o[4] = bf_lo(w.z); o[5] = bf_hi(w.z); o[6] = bf_lo(w.w); o[7] = bf_hi(w.w); }
__device__ __forceinline__ void pool_get(float (&o)[8], bool samp, int b, int t, int ch0, const bf16* U, const float* cpool) {
    if (t < 0) {
        if (samp) { const float* p = cpool + ((size_t)b * PH + (PH + t)) * PW + ch0; const f32x4 x = *(const f32x4*)p, y = *(const f32x4*)(p + 4); o[0] = x[0]; o[1] = x[1]; o[2] = x[2]; o[3] = x[3]; o[4] = y[0]; o[5] = y[1]; o[6] = y[2]; o[7] = y[3]; }
        else {
#pragma unroll
            for (int i = 0; i < 8; ++i) o[i] = 0.f; }
    } else ld8(o, U + ((size_t)(samp ? MP + b * DSEQ + t : b * SEQ + t)) * PW + ch0);
}
__device__ __forceinline__ void pool_phase(const Args& a, int l, int lane, int wave) {
    const int gw = blockIdx.x * 8 + wave, NGW = gridDim.x * 8;
    const bf16* U = (const bf16*)(a.ws + WS_U); bf16* MIX = (bf16*)(a.ws + WS_MIX);
    const float* cpool = a.cache_pool + (size_t)l * 32 * PH * PW;
    constexpr int NPB = MP / 16;
    for (int it = gw; it < 2 * (NPB + NBS); it += NGW) {
        const int hf = it & 1, blk = it >> 1; const bool samp = blk >= NPB;
        const int b = samp ? blk - NPB : blk >> 7, t0 = samp ? 0 : (blk & 127) * 16;
        const int ch = hf * 256 + lane * 4, wl = 1 + 2 * hf + (lane >> 5), w = 1 << wl;
        const size_t rowbase = samp ? (size_t)MP + b * DSEQ : (size_t)b * SEQ + t0;
        f32x4 S[31]; u32x2 raw[31];
#pragma unroll
        for (int i = 0; i < 31; ++i) {
            raw[i] = (u32x2){0u, 0u};
            if (samp && i < 15) S[i] = *(const f32x4*)(cpool + ((size_t)b * PH + i) * PW + ch);
            else if (samp || t0 - 15 + i >= 0) raw[i] = *(const u32x2*)(U + (rowbase + i - 15) * PW + ch);
        }
#pragma unroll
        for (int i = 0; i < 31; ++i) if (!(samp && i < 15)) S[i] = (f32x4){bf_lo(raw[i].x), bf_hi(raw[i].x), bf_lo(raw[i].y), bf_hi(raw[i].y)};
        f32x4 cur[16];
#pragma unroll
        for (int j = 0; j < 16; ++j) cur[j] = S[15 + j];
#pragma unroll
        for (int i = 30; i >= 1; --i) S[i] += S[i - 1];
        if (wl >= 2) {
#pragma unroll
            for (int i = 30; i >= 2; --i) S[i] += S[i - 2]; }
        if (wl >= 3) {
#pragma unroll
            for (int i = 30; i >= 4; --i) S[i] += S[i - 4]; }
        if (wl >= 4) {
#pragma unroll
            for (int i = 30; i >= 8; --i) S[i] += S[i - 8]; }
#pragma unroll
        for (int j = 0; j < 16; ++j) {
            const int t = t0 + j; const float inv = 1.0f / (float)((samp || t + 1 >= w) ? w : t + 1);
            const f32x4 d = S[15 + j] * inv - cur[j];
            u32x2 o; o.x = cvtpk(d[0], d[1]); o.y = cvtpk(d[2], d[3]);
            *(u32x2*)(MIX + (rowbase + j) * DM + ch) = o;
        }
    }
}

constexpr int KS_STRIDE = 144, VT_STRIDE = 408  , LDS_KS = 0, LDS_VT = 192 * KS_STRIDE;
__device__ __forceinline__ void attn_unit(const Args& a, LAS unsigned char* lds, int l, int unit, int tid, int lane, int wave) {
    const bf16 *Qb = (const bf16*)(a.ws + WS_Q), *Kb = (const bf16*)(a.ws + WS_K), *Vb = (const bf16*)(a.ws + WS_V); bf16* MIX = (bf16*)(a.ws + WS_MIX);
    const bool samp = unit < 2 * NBS;
    int b, c = 0, hkv;
    if (samp) { b = unit >> 1; hkv = unit & 1; } else { const int u2 = unit - 2 * NBS; hkv = u2 & 1; c = (u2 >> 1) & 31; b = u2 >> 6; }
    const int lo = samp ? 0 : (c >= 2 ? 0 : (2 - c) * 64), hi = samp ? WIN + DSEQ : 192;
    const u32x4 z4 = {0u, 0u, 0u, 0u};
    const int g = wave >> 1, th = wave & 1, r32 = lane & 31, h = lane >> 5;
    const int tok = 32 * th + r32; const bool rv = !samp || tok < DSEQ;
    const size_t qrow = samp ? (size_t)MP + b * DSEQ + (rv ? tok : 0) : (size_t)b * SEQ + c * 64 + tok;
    const int head = hkv * 4 + g;
    bf16x8 qr[4];
#pragma unroll
    for (int d0 = 0; d0 < 4; ++d0) { u32x4 q4 = z4; if (rv) q4 = *(const u32x4*)(Qb + qrow * AW + head * 64 + d0 * 16 + h * 8); qr[d0] = __builtin_bit_cast(bf16x8, q4); }
    __syncthreads();
    for (int p = tid; p < 192 * 8; p += 512) { const int slot = p >> 3, ch = p & 7; u32x4 val = z4;
        if (slot >= lo && slot < hi) {
            if (samp && slot < WIN) { const float* s = a.cache_k + ((((size_t)l * 32 + b) * WIN + slot) * 2 + hkv) * 64 + ch * 8; val = pack8(*(const f32x4*)s, *(const f32x4*)(s + 4)); }
            else { const size_t grow = samp ? (size_t)MP + b * DSEQ + (slot - WIN) : (size_t)b * SEQ + (c - 2) * 64 + slot; val = *(const u32x4*)(Kb + grow * KVW + hkv * 64 + ch * 8); } }
        *(LAS u32x4*)(lds + LDS_KS + slot * KS_STRIDE + ch * 16) = val; }
    for (int p = tid; p < 96 * 8; p += 512) { const int jp = p >> 3, ch = p & 7, slot = 2 * jp; u32x4 va = z4, vb = z4;
        if (slot >= lo && slot < hi) {
            if (samp && slot < WIN) { const float* s = a.cache_v + ((((size_t)l * 32 + b) * WIN + slot) * 2 + hkv) * 64 + ch * 8; va = pack8(*(const f32x4*)s, *(const f32x4*)(s + 4)); vb = pack8(*(const f32x4*)(s + 128), *(const f32x4*)(s + 132)); }
            else { const size_t grow = samp ? (size_t)MP + b * DSEQ + (slot - WIN) : (size_t)b * SEQ + (c - 2) * 64 + slot; const bf16* s = Vb + grow * KVW + hkv * 64 + ch * 8; va = *(const u32x4*)s; vb = *(const u32x4*)(s + KVW); } }
        LAS unsigned* vt = (LAS unsigned*)(lds + LDS_VT + (ch * 8) * VT_STRIDE + jp * 4);
#pragma unroll
        for (int i = 0; i < 4; ++i) { const unsigned wa = va[i], wb = vb[i];
            vt[(2 * i) * (VT_STRIDE / 4)] = (wa & 0xffffu) | (wb << 16); vt[(2 * i + 1) * (VT_STRIDE / 4)] = (wa >> 16) | (wb & 0xffff0000u); } }
    __syncthreads();
    if (samp && th == 1) return;
    f32x16 s[6];
#pragma unroll
    for (int blk = 0; blk < 6; ++blk) {
#pragma unroll
        for (int i = 0; i < 16; ++i) s[blk][i] = 0.f;
#pragma unroll
        for (int d0 = 0; d0 < 4; ++d0) { const bf16x8 kf = *(const LAS bf16x8*)(lds + LDS_KS + (32 * blk + r32) * KS_STRIDE + d0 * 32 + h * 16); s[blk] = MFMA_BF(kf, qr[d0], s[blk]); }
        __builtin_amdgcn_sched_barrier(0);
    }
    const float sink2 = a.sinks[l * 8 + head] * LOG2E;
    if (lo > 0 || hi < 192) {
#pragma unroll
        for (int blk = 0; blk < 6; ++blk)
#pragma unroll
            for (int i = 0; i < 16; ++i) { const int slot = 32 * blk + crow(i, h); if (slot < lo || slot >= hi) s[blk][i] = -INFINITY; }
    }
    float mx = sink2;
#pragma unroll
    for (int blk = 0; blk < 6; ++blk)
#pragma unroll
        for (int i = 0; i < 16; ++i) mx = fmaxf(mx, s[blk][i]);
    mx = fmaxf(mx, __shfl_xor(mx, 32));
    float sum = 0.f; f32x4 sum4 = {0.f, 0.f, 0.f, 0.f}; u32x4 pk[12];
#pragma unroll
    for (int blk = 0; blk < 6; ++blk) {
        s[blk] = s[blk] - mx;
#pragma unroll
        for (int i = 0; i < 16; ++i) s[blk][i] = __builtin_amdgcn_exp2f(s[blk][i]);
        sum4 += ((f32x4){s[blk][0], s[blk][1], s[blk][2], s[blk][3]} + (f32x4){s[blk][4], s[blk][5], s[blk][6], s[blk][7]}) + ((f32x4){s[blk][8], s[blk][9], s[blk][10], s[blk][11]} + (f32x4){s[blk][12], s[blk][13], s[blk][14], s[blk][15]});
#pragma unroll
        for (int s2 = 0; s2 < 2; ++s2) { pk[2 * blk + s2].x = cvtpk(s[blk][8 * s2], s[blk][8 * s2 + 1]); pk[2 * blk + s2].y = cvtpk(s[blk][8 * s2 + 2], s[blk][8 * s2 + 3]); pk[2 * blk + s2].z = cvtpk(s[blk][8 * s2 + 4], s[blk][8 * s2 + 5]); pk[2 * blk + s2].w = cvtpk(s[blk][8 * s2 + 6], s[blk][8 * s2 + 7]); }
        __builtin_amdgcn_sched_barrier(0);
    }
    sum = (sum4[0] + sum4[1]) + (sum4[2] + sum4[3]);
    sum += __shfl_xor(sum, 32);
    const float inv = 1.0f / (sum + __builtin_amdgcn_exp2f(sink2 - mx));
    if (rv || true) {
        bf16* op = MIX + qrow * DM + 512 + head * 64 + 4 * h;
#pragma unroll
        for (int db = 0; db < 2; ++db) {
            f32x16 o;
#pragma unroll
            for (int i = 0; i < 16; ++i) o[i] = 0.f;
#pragma unroll
            for (int blk = 0; blk < 6; ++blk)
#pragma unroll
                for (int s2 = 0; s2 < 2; ++s2) {
                    const bf16x8 pf = __builtin_bit_cast(bf16x8, pk[2 * blk + s2]);
                    const LAS unsigned char* vp = lds + LDS_VT + (32 * db + r32) * VT_STRIDE + (32 * blk + 16 * s2 + 4 * h) * 2;
                    const s16x4 vlo = *(const LAS s16x4*)vp, vhi = *(const LAS s16x4*)(vp + 16);
                    const bf16x8 vf = {vlo[0], vlo[1], vlo[2], vlo[3], vhi[0], vhi[1], vhi[2], vhi[3]};
                    o = MFMA_BF(vf, pf, o);
                    __builtin_amdgcn_sched_barrier(0);
                }
            if (rv) {
#pragma unroll
                for (int ig = 0; ig < 4; ++ig) { u32x2 w; w.x = cvtpk(o[4 * ig] * inv, o[4 * ig + 1] * inv); w.y = cvtpk(o[4 * ig + 2] * inv, o[4 * ig + 3] * inv); *(u32x2*)(op + 32 * db + 8 * ig) = w; } }
        }
    }
}

__device__ __forceinline__ void state_phase(const Args& a, int l, int tid) {
    const bf16 *U = (const bf16*)(a.ws + WS_U), *Kb = (const bf16*)(a.ws + WS_K), *Vb = (const bf16*)(a.ws + WS_V);
    constexpr int N_PP = 32 * PH * (PW / 8), N_KP = 32 * WIN * (KVW / 8), N_PS = 32 * PH * (PW / 8), N_KS = 32 * DSEQ * (KVW / 8), NTOT = N_PP + 2 * N_KP + N_PS + 2 * N_KS;
    for (int i = blockIdx.x * 512 + tid; i < NTOT; i += gridDim.x * 512) {
        int q = i; const bf16* src; float* dst;
        if (q < N_PP) { const int c8 = q % (PW / 8), t = (q / (PW / 8)) % PH, b = q / (PW / 8 * PH);
            src = U + ((size_t)b * SEQ + (SEQ - PH) + t) * PW + 8 * c8; dst = a.out + O_POOLP + (((size_t)l * 32 + b) * PH + t) * PW + 8 * c8; }
        else if ((q -= N_PP) < 2 * N_KP) { const int kv = q >= N_KP; if (kv) q -= N_KP; const int c8 = q % (KVW / 8), t = (q / (KVW / 8)) % WIN, b = q / (KVW / 8 * WIN);
            src = (kv ? Vb : Kb) + ((size_t)b * SEQ + (SEQ - WIN) + t) * KVW + 8 * c8; dst = a.out + (kv ? O_VP : O_KP) + (((size_t)l * 32 + b) * WIN + t) * KVW + 8 * c8; }
        else if ((q -= 2 * N_KP) < N_PS) { const int c8 = q % (PW / 8), t = (q / (PW / 8)) % PH, b = q / (PW / 8 * PH);
            src = U + ((size_t)MP + b * DSEQ + 1 + t) * PW + 8 * c8; dst = a.out + O_POOLS + (((size_t)l * 32 + b) * PH + t) * PW + 8 * c8; }
        else { q -= N_PS; const int kv = q >= N_KS; if (kv) q -= N_KS; const int c8 = q % (KVW / 8), t = (q / (KVW / 8)) % DSEQ, b = q / (KVW / 8 * DSEQ);
            src = (kv ? Vb : Kb) + ((size_t)MP + b * DSEQ + t) * KVW + 8 * c8; dst = a.out + (kv ? O_VS : O_KS) + (((size_t)l * 32 + b) * WIN + (WIN - DSEQ) + t) * KVW + 8 * c8; }
        float v[8]; ld8(v, src);
        *(f32x4*)dst = (f32x4){v[0], v[1], v[2], v[3]}; *(f32x4*)(dst + 4) = (f32x4){v[4], v[5], v[6], v[7]};
    }
}


template <int KS, class F>
__device__ __forceinline__ void side_gemm(LAS unsigned char* lds, const bf16* A, const bf16* Bt, int K, int ncp, const F& f, int tid, int wave) {
    constexpr int NSUB = 8 / KS;
    const int lane = tid & 63, r = lane & 31, h = lane >> 5, kc = wave & (KS - 1), sub = wave / KS, nitems = (MS / 32) * ncp, Kc = K / KS;
    LAS float* red = (LAS float*)lds + sub * ((KS > 1 ? KS - 1 : 1) * 32 * 64);
    for (int it0 = blockIdx.x * NSUB; it0 < nitems; it0 += gridDim.x * NSUB) {
        const int it = it0 + sub; const bool act = it < nitems; const int rb = it & 15, cp = it >> 4;
        f32x16 c0, c1;
#pragma unroll
        for (int i = 0; i < 16; ++i) { c0[i] = 0.f; c1[i] = 0.f; }
        if (act) {
            const bf16* ap = A + (size_t)(rb * 32 + r) * K + kc * Kc + 8 * h;
            const bf16* b0 = Bt + (size_t)((cp >> 2) * 256 + (cp & 3) * 32 + r) * K + kc * Kc + 8 * h; const bf16* b1 = b0 + (size_t)128 * K;
#pragma unroll (KS == 1 ? 16 : 8)
            for (int k = 0; k < Kc; k += 16) { const bf16x8 af = *(const bf16x8*)(ap + k), w0 = *(const bf16x8*)(b0 + k), w1 = *(const bf16x8*)(b1 + k); c0 = MFMA_BF(w0, af, c0); c1 = MFMA_BF(w1, af, c1); }
            if (KS > 1 && kc != 0) {
#pragma unroll
                for (int i = 0; i < 16; ++i) { red[((kc - 1) * 32 + i) * 64 + lane] = c0[i]; red[((kc - 1) * 32 + 16 + i) * 64 + lane] = c1[i]; } }
        }
        if (KS > 1) __syncthreads();
        if (act && kc == 0) {
            if (KS > 1) {
#pragma unroll (KS > 4 ? 1 : 3)
                for (int p = 0; p < KS - 1; ++p)
#pragma unroll
                    for (int i = 0; i < 16; ++i) { c0[i] += red[(p * 32 + i) * 64 + lane]; c1[i] += red[(p * 32 + 16 + i) * 64 + lane]; } }
            f(MP + rb * 32 + r, h, cp, c0, c1);
        }
        if (KS > 1) __syncthreads();
    }
    if (KS == 1) __syncthreads();
}
#define V4(c, ig) ((f32x4){c[4 * (ig)], c[4 * (ig) + 1], c[4 * (ig) + 2], c[4 * (ig) + 3]})
__device__ __forceinline__ u32x2 pack4(f32x4 v) { u32x2 w; w.x = cvtpk(v[0], v[1]); w.y = cvtpk(v[2], v[3]); return w; }
__device__ __forceinline__ float row_rstd(const float* rss, int row) { const f32x4* p = (const f32x4*)(rss + (size_t)row * 16); const f32x4 a = p[0], b = p[1], c = p[2], d = p[3];
    return rsqrtf((((a[0] + a[1]) + (a[2] + a[3])) + ((b[0] + b[1]) + (b[2] + b[3])) + ((c[0] + c[1]) + (c[2] + c[3])) + ((d[0] + d[1]) + (d[2] + d[3]))) * (1.0f / DM) + EPS); }
struct SIn { const float* rss; const float* bias; bf16 *U, *Q, *K, *V;
    __device__ __forceinline__ void operator()(int row, int h, int cp, const f32x16& c0, const f32x16& c1) const {
        const int pn = cp >> 2, cb = pn * 256 + (cp & 3) * 32 + 4 * h; bf16 *d0, *d1; int pitch; float sc = 1.f;
        if (pn < 2) { d0 = U + cb; d1 = d0 + 128; pitch = PW; } else if (pn < 4) { d0 = Q + (cb - 512); d1 = d0 + 128; pitch = AW; sc = QSCALE; } else { d0 = K + (cb - 1024); d1 = V + (cb - 1024); pitch = KVW; }
        const float rs = row_rstd(rss, row) * sc; const float* bp = bias + (size_t)pg8::row_seq(row) * INW + cb;
#pragma unroll
        for (int ig = 0; ig < 4; ++ig) { *(u32x2*)(d0 + (size_t)row * pitch + 8 * ig) = pack4(V4(c0, ig) * rs + *(const f32x4*)(bp + 8 * ig) * sc); *(u32x2*)(d1 + (size_t)row * pitch + 8 * ig) = pack4(V4(c1, ig) * rs + *(const f32x4*)(bp + 128 + 8 * ig) * sc); }
    } };
struct SRes { bf16* xn; const float* gate; const float* psc; const float* pg; const float* nsc; const float* ng; float* rss;
    __device__ __forceinline__ void operator()(int row, int h, int cp, const f32x16& c0, const f32x16& c1) const {
        const int cb = (cp >> 2) * 256 + (cp & 3) * 32 + 4 * h; const size_t so = (size_t)pg8::row_seq(row) * (6 * DM); float ss = 0.f;
#pragma unroll
        for (int hb = 0; hb < 2; ++hb)
#pragma unroll
            for (int ig = 0; ig < 4; ++ig) { const int c = cb + hb * 128 + 8 * ig; const u32x2 w = *(const u32x2*)(xn + (size_t)row * DM + c);
                const f32x4 x = (f32x4){bf_lo(w.x), bf_hi(w.x), bf_lo(w.y), bf_hi(w.y)} * (1.0f / pg8::gm4(*(const f32x4*)(pg + c), *(const f32x4*)(psc + so + c))) + *(const f32x4*)(gate + so + c) * (hb ? V4(c1, ig) : V4(c0, ig));
                ss += (x[0] * x[0] + x[1] * x[1]) + (x[2] * x[2] + x[3] * x[3]);
                *(u32x2*)(xn + (size_t)row * DM + c) = pack4(nsc ? x * pg8::gm4(*(const f32x4*)(ng + c), *(const f32x4*)(nsc + so + c)) : x); }
        ss += __shfl_xor(ss, 32); if (h == 0) rss[(size_t)row * 16 + cp] = ss;
    } };
struct SGU { const float* rss; const float* bias; bf16* H;
    __device__ __forceinline__ void operator()(int row, int h, int cp, const f32x16& c0, const f32x16& c1) const {
        const int pn = cp >> 2, wc = cp & 3; const float rs = row_rstd(rss, row); const float* bp = bias + (size_t)pg8::row_seq(row) * NGU + pn * 256 + wc * 32 + 4 * h;
#pragma unroll
        for (int ig = 0; ig < 4; ++ig) { const f32x4 a = V4(c0, ig) * rs + *(const f32x4*)(bp + 8 * ig), b = V4(c1, ig) * rs + *(const f32x4*)(bp + 128 + 8 * ig); f32x4 o;
#pragma unroll
            for (int i = 0; i < 4; ++i) o[i] = a[i] * b[i] * __builtin_amdgcn_rcpf(1.0f + __builtin_amdgcn_exp2f(-LOG2E * a[i]));
            *(u32x2*)(H + (size_t)row * DFF + pn * 128 + wc * 32 + 4 * h + 8 * ig) = pack4(o); }
    } };

#define CAS __attribute__((address_space(4)))
__device__ __forceinline__ Args load_args(const CAS Args* p) {
#if defined(__HIP_DEVICE_COMPILE__)
    asm volatile("" : "+s"(p)); Args r; const CAS unsigned long long* q = (const CAS unsigned long long*)p; const float** d = (const float**)&r;
#pragma unroll
    for (int i = 0; i < (int)(sizeof(Args) / 8); ++i) d[i] = (const float*)(const __attribute__((address_space(1))) float*)q[i];
    return r;
#else
    return Args{};
#endif
}
__device__ __forceinline__ int mk_tid(int wave) { unsigned z; asm volatile("s_mov_b32 %0, 0" : "=s"(z)); return wave * 64 + (int)__builtin_amdgcn_mbcnt_hi(~0u, __builtin_amdgcn_mbcnt_lo(~0u, z)); }
__global__ void __launch_bounds__(512, 2) fwd_megakernel(Args a_kernarg) {
    extern __shared__ __attribute__((aligned(16))) unsigned char lds_raw[];
    LAS unsigned char* lds = (LAS unsigned char*)lds_raw;
    cg::grid_group grid = cg::this_grid();
    const CAS Args* ap = (const CAS Args*)__builtin_amdgcn_kernarg_segment_ptr();
    const int wave = __builtin_amdgcn_readfirstlane(threadIdx.x >> 6), G = gridDim.x, bx = blockIdx.x;
    if (threadIdx.x < 64) ((LAS unsigned*)(lds + XB_LDS_OFF))[threadIdx.x] = 0u;
    __syncthreads();
    { const Args a = load_args(ap); (void)xcd_barrier_post((unsigned*)(a.ws + WS_CTL), (volatile LAS unsigned*)(lds + XB_LDS_OFF)); }
#define GRID_BAR() do { const Args a_ = load_args(ap); XcdBarrier b_; b_.bar = (unsigned*)(a_.ws + WS_CTL); b_.x = xb_xcc_id(); b_.st = (volatile LAS unsigned*)(lds + XB_LDS_OFF); xcd_barrier(b_); } while (0)
#ifndef SKIP_P0
#if defined(PROBE_P0X2) || defined(PROBE_P0AX2)
    { const Args a = load_args(ap); const int tid = mk_tid(wave); phase0a(a, lds, tid, tid & 63, wave, 18); }
    GRID_BAR();
#endif
#ifdef PROBE_P0X2
    { const Args a = load_args(ap); const int tid = mk_tid(wave); phase0b(a, lds, tid, tid & 63, wave, 19); }
    GRID_BAR();
#endif
    { const Args a = load_args(ap); const int tid = mk_tid(wave); phase0a(a, lds, tid, tid & 63, wave); }
    grid.sync();
    { const Args a = load_args(ap); const int tid = mk_tid(wave); phase0b(a, lds, tid, tid & 63, wave); }
    GRID_BAR();
#endif
#pragma nounroll
    for (int l = 0; l < DEPTH; ++l) {
#ifndef SKIP_P1
        {
            const Args a = load_args(ap);
            { const int tid = mk_tid(wave); SIn F{(const float*)(a.ws + WS_RSS), (const float*)(a.ws + WS_BIN) + (size_t)l * NSEQ * INW, (bf16*)(a.ws + WS_U), (bf16*)(a.ws + WS_Q), (bf16*)(a.ws + WS_K), (bf16*)(a.ws + WS_V)};
              side_gemm<4>(lds, (const bf16*)(a.ws + WS_XN) + (size_t)MP * DM, (const bf16*)(a.ws + WS_WIN) + (size_t)l * INW * DM, DM, INW / 64, F, tid, wave); }
            pg8::Gemm g{(const bf16*)(a.ws + WS_XN), (const bf16*)(a.ws + WS_WIN) + (size_t)l * INW * DM, MP, INW, DM}; pg8::StaticOrder S; S.init(MP, INW, G, bx);
            pg8::EpiIn E{(const float*)(a.ws + WS_RSS), (const float*)(a.ws + WS_BIN) + (size_t)l * NSEQ * INW, (bf16*)(a.ws + WS_U), (bf16*)(a.ws + WS_Q), (bf16*)(a.ws + WS_K), (bf16*)(a.ws + WS_V)};
            pg8::gemm_phase<pg8::EpiIn, pg8::StaticOrder, true, true>(lds, g, S, E, mk_tid(wave));
#ifdef PROBE_P1X2
            asm volatile("" ::: "memory"); pg8::gemm_phase<pg8::EpiIn, pg8::StaticOrder, true, true>(lds, g, S, E, mk_tid(wave));
#endif
        }
#endif
        GRID_BAR();
#ifndef SKIP_P2
        {
            const Args a = load_args(ap); const int tid = mk_tid(wave), lane = tid & 63;
#ifdef PROBE_P2X2
            for (int rep = 0; rep < 2; ++rep) { asm volatile("" ::: "memory");
#endif
            state_phase(a, l, tid);
            pool_phase(a, l, lane, wave);
            for (int unit = bx; unit < 2 * NBS + NBP * 32 * 2; unit += G) attn_unit(a, lds, l, unit, tid, lane, wave);
            __syncthreads();
#ifdef PROBE_P2X2
            }
#endif
        }
#endif
        GRID_BAR();
#ifndef SKIP_P3
        {
            const Args a = load_args(ap);
            bf16* X = (bf16*)(a.ws + WS_XN); const float* modl = (const float*)(a.ws + WS_MOD) + (size_t)l * NSEQ * 6 * DM;
            { const int tid = mk_tid(wave); SRes F{X, modl + 2 * DM, modl + DM, a.g_mix + l * DM, modl + 4 * DM, a.g_ffn + l * DM, (float*)(a.ws + WS_RSS)};
              side_gemm<8>(lds, (const bf16*)(a.ws + WS_MIX) + (size_t)MP * DM, (const bf16*)(a.ws + WS_WO) + (size_t)l * DM * DM, DM, DM / 64, F, tid, wave); }
            pg8::Gemm g{(const bf16*)(a.ws + WS_MIX), (const bf16*)(a.ws + WS_WO) + (size_t)l * DM * DM, MP, DM, DM}; pg8::StaticOrder S; S.init(MP, DM, G, bx, 1);
            pg8::EpiRes E{X, modl + 2 * DM, modl + DM, a.g_mix + l * DM, modl + 4 * DM, a.g_ffn + l * DM, (float*)(a.ws + WS_RSS), (LAS float*)(lds + EPI_LDS_OFF)};
            pg8::gemm_phase<pg8::EpiRes, pg8::StaticOrder, true, true>(lds, g, S, E, mk_tid(wave));
        }
#endif
        GRID_BAR();
#ifndef SKIP_P4
        {
            const Args a = load_args(ap);
            { const int tid = mk_tid(wave); SGU F{(const float*)(a.ws + WS_RSS), (const float*)(a.ws + WS_BGU) + (size_t)l * NSEQ * NGU, (bf16*)(a.ws + WS_H)};
              side_gemm<1>(lds, (const bf16*)(a.ws + WS_XN) + (size_t)MP * DM, (const bf16*)(a.ws + WS_WGU) + (size_t)l * NGU * DM, DM, NGU / 64, F, tid, wave); }
            pg8::Gemm g{(const bf16*)(a.ws + WS_XN), (const bf16*)(a.ws + WS_WGU) + (size_t)l * NGU * DM, MP, NGU, DM}; pg8::StaticOrder S; S.init(MP, NGU, G, bx);
            pg8::EpiGU E{(const float*)(a.ws + WS_RSS), (const float*)(a.ws + WS_BGU) + (size_t)l * NSEQ * NGU, (bf16*)(a.ws + WS_H), (LAS float*)(lds + EGU_LDS_OFF)};
            pg8::gemm_phase<pg8::EpiGU, pg8::StaticOrder, true, true>(lds, g, S, E, mk_tid(wave));
#ifdef PROBE_P4X2
            asm volatile("" ::: "memory"); pg8::gemm_phase<pg8::EpiGU, pg8::StaticOrder, true, true>(lds, g, S, E, mk_tid(wave));
#endif
        }
#endif
        GRID_BAR();
#ifndef SKIP_P5
        {
            const Args a = load_args(ap);
            bf16* X = (bf16*)(a.ws + WS_XN); const float* modl = (const float*)(a.ws + WS_MOD) + (size_t)l * NSEQ * 6 * DM;
            const bool last = l == DEPTH - 1;
            { const int tid = mk_tid(wave); SRes F{X, modl + 5 * DM, modl + 4 * DM, a.g_ffn + l * DM, last ? nullptr : modl + NSEQ * 6 * DM + DM, a.g_mix + (last ? 0 : (l + 1) * DM), (float*)(a.ws + WS_RSS)};
              side_gemm<8>(lds, (const bf16*)(a.ws + WS_H) + (size_t)MP * DFF, (const bf16*)(a.ws + WS_WD) + (size_t)l * DM * DFF, DFF, DM / 64, F, tid, wave); }
            pg8::Gemm g{(const bf16*)(a.ws + WS_H), (const bf16*)(a.ws + WS_WD) + (size_t)l * DM * DFF, MP, DM, DFF}; pg8::StaticOrder S; S.init(MP, DM, G, bx, 1);
            pg8::EpiRes E{X, modl + 5 * DM, modl + 4 * DM, a.g_ffn + l * DM, last ? nullptr : modl + NSEQ * 6 * DM + DM, a.g_mix + (last ? 0 : (l + 1) * DM), (float*)(a.ws + WS_RSS), (LAS float*)(lds + EPI_LDS_OFF)};
            pg8::gemm_phase<pg8::EpiRes, pg8::StaticOrder, true, true>(lds, g, S, E, mk_tid(wave));
        }
#endif
        GRID_BAR();
    }
    {
        const Args a = load_args(ap); const int lane = mk_tid(wave) & 63;
        const bf16* X = (const bf16*)(a.ws + WS_XN); const float* rss = (const float*)(a.ws + WS_RSS);
        f32x4 g0[2], g1[2];
#pragma unroll
        for (int j = 0; j < 2; ++j) { g0[j] = *(const f32x4*)(a.g_final + 8 * (lane + 64 * j)); g1[j] = *(const f32x4*)(a.g_final + 8 * (lane + 64 * j) + 4); }
#pragma unroll 2
        for (int row = bx * 8 + wave; row < MT; row += G * 8) {
            const float pr = lane < 16 ? rss[(size_t)row * 16 + lane] : 0.f;
            const u32x4 w0 = *(const u32x4*)(X + (size_t)row * DM + 8 * lane), w1 = *(const u32x4*)(X + (size_t)row * DM + 8 * (lane + 64));
            const float rstd = rsqrtf(wave_sum(pr) * (1.0f / DM) + EPS);
            float* yr = a.out + (size_t)row * DM; f32x4 lo, hi;
            pg8::unpack8(w0, lo, hi); *(f32x4*)(yr + 8 * lane) = lo * rstd * g0[0]; *(f32x4*)(yr + 8 * lane + 4) = hi * rstd * g1[0];
            pg8::unpack8(w1, lo, hi); *(f32x4*)(yr + 8 * (lane + 64)) = lo * rstd * g0[1]; *(f32x4*)(yr + 8 * (lane + 64) + 4) = hi * rstd * g1[1];
        }
    }
}

extern "C" void kernel_launch(void* const* d_in, const int* in_sizes, int n_in, void* d_out, int out_size, void* d_ws, size_t ws_size, hipStream_t stream) {
    static int grid = 0;
    if (grid == 0) {
        if (n_in != 19 || (size_t)out_size != O_END || ws_size < WS_TOTAL) { fprintf(stderr, "kernel_launch: shape mismatch (n_in %d out %d ws %zu need %zu)\n", n_in, out_size, ws_size, (size_t)WS_TOTAL); grid = -1; return; }
        int dev = 0, cus = 0, per_cu = 0;
        hipGetDevice(&dev); hipDeviceGetAttribute(&cus, hipDeviceAttributeMultiprocessorCount, dev);
        if (hipFuncSetAttribute((const void*)fwd_megakernel, hipFuncAttributeMaxDynamicSharedMemorySize, LDS_BYTES) != hipSuccess) { fprintf(stderr, "kernel_launch: hipFuncSetAttribute failed\n"); grid = -1; return; }
        if (hipOccupancyMaxActiveBlocksPerMultiprocessor(&per_cu, (const void*)fwd_megakernel, 512, LDS_BYTES) != hipSuccess || per_cu < 1) { fprintf(stderr, "kernel_launch: occupancy query says %d\n", per_cu); per_cu = 1; }
        (void)hipGetLastError();
        grid = cus;
    }
    if (grid < 0) return;
    if (hipMemsetAsync((char*)d_ws + WS_CTL, 0, CTL_BYTES, stream) != hipSuccess) { fprintf(stderr, "kernel_launch: memset failed\n"); return; }
    Args a{};
    const float** f = (const float**)&a;
    for (int i = 0; i < 19; ++i) f[i] = (const float*)d_in[i];
    a.out = (float*)d_out; a.ws = (unsigned char*)d_ws;
    void* args[] = {&a};
    hipError_t e = hipLaunchCooperativeKernel((const void*)fwd_megakernel, dim3(grid), dim3(512), args, LDS_BYTES, stream);
    if (e != hipSuccess) fprintf(stderr, "kernel_launch: cooperative launch failed: %s (grid %d)\n", hipGetErrorString(e), grid);
}
```

```cpp
#include <hip/hip_runtime.h>
#include <hip/hip_cooperative_groups.h>
#include <cstdio>
#include <cstdint>
namespace cg = cooperative_groups;

constexpr int DM = 1024, NBP = 32, SEQ = 2048, DEPTH = 4, NBS = 32, DSEQ = 16;
constexpr int MP = NBP * SEQ, MS = NBS * DSEQ, MT = MP + MS;
constexpr int PW = 512, AW = 512, KVW = 128, INW = 1280, DFF = 2816, NGU = 2 * DFF, NSEQ = 64, WIN = 128, PH = 15;
constexpr float EPS = 1e-6f;
constexpr float QSCALE = 0.125f * 1.4426950408889634f;
constexpr float LOG2E = 1.4426950408889634f;
constexpr size_t O_YP = 0, O_YS = (size_t)MP * DM, O_POOLP = O_YS + (size_t)MS * DM, SZ_POOL = (size_t)DEPTH * 32 * PH * PW, SZ_KV = (size_t)DEPTH * 32 * WIN * KVW;
constexpr size_t O_KP = O_POOLP + SZ_POOL, O_VP = O_KP + SZ_KV, O_POOLS = O_VP + SZ_KV, O_KS = O_POOLS + SZ_POOL, O_VS = O_KS + SZ_KV, O_END = O_VS + SZ_KV;
constexpr size_t WS_WIN = 0, WS_WO = WS_WIN + (size_t)DEPTH * INW * DM * 2, WS_WGU = WS_WO + (size_t)DEPTH * DM * DM * 2, WS_WD = WS_WGU + (size_t)DEPTH * NGU * DM * 2;
constexpr size_t WS_MOD = WS_WD + (size_t)DEPTH * DM * DFF * 2, WS_BIN = WS_MOD + (size_t)DEPTH * NSEQ * 6 * DM * 4, WS_BGU = WS_BIN + (size_t)DEPTH * NSEQ * INW * 4;
constexpr size_t WS_RSS = WS_BGU + (size_t)DEPTH * NSEQ * NGU * 4, WS_XN = WS_RSS + (size_t)MT * 16 * 4, WS_U = WS_XN + (size_t)MT * DM * 2;
constexpr size_t WS_Q = WS_U + (size_t)MT * PW * 2, WS_K = WS_Q + (size_t)MT * AW * 2, WS_V = WS_K + (size_t)MT * KVW * 2, WS_MIX = WS_V + (size_t)MT * KVW * 2;
constexpr size_t WS_H = WS_U  , WS_END = WS_H + (size_t)MT * DFF * 2;
static_assert(WS_MIX + (size_t)MT * DM * 2 <= WS_END, "H overlay covers U..MIX");
constexpr size_t WS_CTL = (WS_END + 4095) / 4096 * 4096, CTL_BYTES = 16384;
constexpr size_t WS_TOTAL = WS_CTL + CTL_BYTES;
constexpr int LDS_BYTES = 147456, XB_LDS_OFF = 131072 + 1024, EPI_LDS_OFF = 131072 + 2048, EGU_LDS_OFF = EPI_LDS_OFF + 6144;

namespace pg8 {
#define PG8_LAS __attribute__((address_space(3)))
typedef unsigned short bf16_t;
typedef short bf16x8 __attribute__((ext_vector_type(8)));
typedef float f32x4 __attribute__((ext_vector_type(4)));
typedef unsigned u32x4 __attribute__((ext_vector_type(4)));
constexpr int BM = 256, BK = 64, HALF = 128, HTB = HALF * BK * 2  , STAGE_BYTES = 8 * HTB, NXCD = 8, WGM = 4;

__host__ __device__ __forceinline__ int lds_byte(int r, int c) { const int st = (r >> 4) * 2 + (c >> 5), rr = r & 15, cc = c & 31, ob = rr * 64 + cc * 2; return st * 1024 + (ob ^ (((ob >> 9) & 1) << 5)); }
__host__ __device__ __forceinline__ void stage_rc(int b, int& R, int& C) { const int st = b / 1024, sb = b % 1024, swz = sb ^ (((sb >> 9) & 1) << 5); R = (st >> 1) * 16 + swz / 64; C = (st & 1) * 32 + (swz % 64) / 2; }
__host__ __device__ __forceinline__ int perm32(int rho) { const int n = rho >> 4, i = rho & 15; return 8 * (i >> 2) + 4 * n + (i & 3); }

struct Unit { int pm, pn; };
struct Gemm { const bf16_t* A; const bf16_t* Bt; int M, N, K; };

struct StaticOrder {
    int nM, nN, nwg, G, c, rev;
    __host__ __device__ void init(int M, int N, int G_, int c_, int rev_ = 0) { nM = M / BM; nN = N / BM; nwg = nM * nN; G = G_; c = c_; rev = rev_; }
    __host__ __device__ bool next(int i, Unit& u) const {
        const long L = (long)i * G + c; if (L >= nwg) return false;
        int wgid = (int)L; { const int q = nwg / NXCD, r = nwg % NXCD, xcd = wgid % NXCD, off = wgid / NXCD; wgid = (xcd < r ? xcd * (q + 1) : r * (q + 1) + (xcd - r) * q) + off; }
        const int nig = WGM * nN, gid = wgid / nig, fm = gid * WGM, gsz = (nM - fm) < WGM ? (nM - fm) : WGM;
        u.pm = fm + ((wgid % nig) % gsz); u.pn = (wgid % nig) / gsz; if (rev) u.pm = (u.pm & ~31) | (31 - (u.pm & 31)); return true;
    }
    __device__ __forceinline__ void a_ready(const Unit&) const {}
    __device__ __forceinline__ void done(const Unit&) const {}
};


typedef float f32x2_t __attribute__((ext_vector_type(2))); typedef __bf16 bf16x2_t __attribute__((ext_vector_type(2)));
__device__ __forceinline__ unsigned cvtpk(float lo, float hi) { f32x2_t v = {lo, hi}; bf16x2_t b = __builtin_convertvector(v, bf16x2_t); return __builtin_bit_cast(unsigned, b); }
__device__ __forceinline__ u32x4 pack8(f32x4 a, f32x4 b) { u32x4 w; w.x = cvtpk(a[0], a[1]); w.y = cvtpk(a[2], a[3]); w.z = cvtpk(b[0], b[1]); w.w = cvtpk(b[2], b[3]); return w; }
__device__ __forceinline__ int row_seq(int row) { return row < MP ? (row >> 11) : 32 + ((row - MP) >> 4); }
__device__ __forceinline__ void load_rstd(float (&rs)[2][4], const float* rss, const Unit& u, int wr, int fr, int fq) {
#pragma unroll
    for (int ai = 0; ai < 2; ++ai)
#pragma unroll
        for (int m = 0; m < 4; ++m) { const int row = u.pm * BM + ai * HALF + wr * 64 + m * 16 + fr; const f32x4 p = *(const f32x4*)(rss + (size_t)row * 16 + fq * 4);
            float s = (p[0] + p[1]) + (p[2] + p[3]); s += __shfl_xor(s, 16); s += __shfl_xor(s, 32); rs[ai][m] = rsqrtf(s * (1.0f / DM) + EPS); }
}

struct EpiIn {
    static constexpr bool PERM = true, AFTER_DRAIN = false, WANTS_NEXT = false;
    const float* rss; const float* bias;
    bf16_t *U, *Q, *K, *V;
    __device__ __forceinline__ void operator()(const f32x4 (&acc)[2][2][4][2], const Unit& u, int wr, int wc, int fr, int fq) const {
        const int ct = u.pn * BM, cl = wc * 32 + 8 * fq;
        bf16_t *d0, *d1; int pitch; float sc = 1.f;
        if (ct < 512) { d0 = U + ct + cl; d1 = d0 + HALF; pitch = PW; }
        else if (ct < 1024) { d0 = Q + (ct - 512) + cl; d1 = d0 + HALF; pitch = AW; sc = QSCALE; }
        else { d0 = K + cl; d1 = V + cl; pitch = KVW; }
        const float* bp = bias + (size_t)(u.pm >> 3) * INW + ct + cl;
        float rs[2][4]; load_rstd(rs, rss, u, wr, fr, fq);
        const f32x4 b0 = *(const f32x4*)bp * sc, b1 = *(const f32x4*)(bp + 4) * sc, b2 = *(const f32x4*)(bp + HALF) * sc, b3 = *(const f32x4*)(bp + HALF + 4) * sc;
#pragma unroll
        for (int ai = 0; ai < 2; ++ai)
#pragma unroll
            for (int m = 0; m < 4; ++m) {
                const size_t ro = (size_t)(u.pm * BM + ai * HALF + wr * 64 + m * 16 + fr) * pitch; const float r = rs[ai][m] * sc;
                *(u32x4*)(d0 + ro) = pack8(acc[ai][0][m][0] * r + b0, acc[ai][0][m][1] * r + b1);
                *(u32x4*)(d1 + ro) = pack8(acc[ai][1][m][0] * r + b2, acc[ai][1][m][1] * r + b3);
            }
    }
};

__device__ __forceinline__ void unpack8(u32x4 w, f32x4& lo, f32x4& hi) {
    lo = (f32x4){__uint_as_float(w.x << 16), __uint_as_float(w.x & 0xffff0000u), __uint_as_float(w.y << 16), __uint_as_float(w.y & 0xffff0000u)};
    hi = (f32x4){__uint_as_float(w.z << 16), __uint_as_float(w.z & 0xffff0000u), __uint_as_float(w.w << 16), __uint_as_float(w.w & 0xffff0000u)}; }
__device__ __forceinline__ f32x4 gm4(f32x4 g, f32x4 sc) { f32x4 v = g * (sc + 1.0f);
#pragma unroll
    for (int i = 0; i < 4; ++i) v[i] = __builtin_fabsf(v[i]) < 1e-6f ? __builtin_copysignf(1e-6f, v[i]) : v[i];
    return v; }
struct EpiRes {
    static constexpr bool PERM = true, AFTER_DRAIN = false, WANTS_NEXT = false;
    bf16_t* xn;
    const float* gate;
    const float* psc; const float* pg;
    const float* nsc; const float* ng;
    float* rss;
    PG8_LAS float* sv;
    __device__ __forceinline__ void operator()(const f32x4 (&acc)[2][2][4][2], const Unit& u, int wr, int wc, int fr, int fq) const {
        float ss[2][4];
#pragma unroll
        for (int ai = 0; ai < 2; ++ai)
#pragma unroll
            for (int m = 0; m < 4; ++m) ss[ai][m] = 0.f;
        const size_t so = (size_t)(u.pm >> 3) * (6 * DM);
        PG8_LAS float* sw = sv + (wr * 4 + wc) * 192 + fq * 8;
        {
            const int vb = fr >> 3, e = fr & 7, c = u.pn * BM + vb * HALF + wc * 32 + 8 * fq + e;
            float gp = pg[c] * (psc[so + c] + 1.0f); gp = __builtin_fabsf(gp) < 1e-6f ? __builtin_copysignf(1e-6f, gp) : gp;
            float gn = 1.0f; if (nsc) { gn = ng[c] * (nsc[so + c] + 1.0f); gn = __builtin_fabsf(gn) < 1e-6f ? __builtin_copysignf(1e-6f, gn) : gn; }
            sw[(vb * 3) * 32 + e] = gate[so + c]; sw[(vb * 3 + 1) * 32 + e] = 1.0f / gp; sw[(vb * 3 + 2) * 32 + e] = gn;
        }
#pragma unroll
        for (int bj = 0; bj < 2; ++bj) {
            const int c0 = u.pn * BM + bj * HALF + wc * 32 + 8 * fq;
            u32x4 xr[2][4];
#pragma unroll
            for (int ai = 0; ai < 2; ++ai)
#pragma unroll
                for (int m = 0; m < 4; ++m) xr[ai][m] = *(const u32x4*)(xn + (size_t)(u.pm * BM + ai * HALF + wr * 64 + m * 16 + fr) * DM + c0);
            asm volatile("s_waitcnt lgkmcnt(0)" ::: "memory");
#pragma unroll
            for (int ai = 0; ai < 2; ++ai)
#pragma unroll
                for (int m = 0; m < 4; ++m) {
                    const size_t ro = (size_t)(u.pm * BM + ai * HALF + wr * 64 + m * 16 + fr) * DM + c0;
                    f32x4 x0, x1; unpack8(xr[ai][m], x0, x1);
                    x0 = x0 * *(const PG8_LAS f32x4*)(sw + (bj * 3 + 1) * 32) + *(const PG8_LAS f32x4*)(sw + (bj * 3) * 32) * acc[ai][bj][m][0];
                    x1 = x1 * *(const PG8_LAS f32x4*)(sw + (bj * 3 + 1) * 32 + 4) + *(const PG8_LAS f32x4*)(sw + (bj * 3) * 32 + 4) * acc[ai][bj][m][1];
                    ss[ai][m] += ((x0[0] * x0[0] + x0[1] * x0[1]) + (x0[2] * x0[2] + x0[3] * x0[3])) + ((x1[0] * x1[0] + x1[1] * x1[1]) + (x1[2] * x1[2] + x1[3] * x1[3]));
                    *(u32x4*)(xn + ro) = pack8(x0 * *(const PG8_LAS f32x4*)(sw + (bj * 3 + 2) * 32), x1 * *(const PG8_LAS f32x4*)(sw + (bj * 3 + 2) * 32 + 4));
                    if (m == 3) asm volatile("" ::: "memory");
                }
        }
#pragma unroll
        for (int ai = 0; ai < 2; ++ai)
#pragma unroll
            for (int m = 0; m < 4; ++m) { float s = ss[ai][m]; s += __shfl_xor(s, 16); s += __shfl_xor(s, 32);
                if (fq == 0) rss[(size_t)(u.pm * BM + ai * HALF + wr * 64 + m * 16 + fr) * 16 + u.pn * 4 + wc] = s; }
    }
};

struct EpiGU {
    static constexpr bool PERM = true, AFTER_DRAIN = false, WANTS_NEXT = true;
    const float* rss; const float* bias;
    bf16_t* H;
    PG8_LAS float* st;
    __device__ __forceinline__ void fetch(const Unit& u, int wr, int wc, int fr, int fq, f32x4 (&pp)[2][4], f32x4 (&bb)[4]) const {
#pragma unroll
        for (int ai = 0; ai < 2; ++ai)
#pragma unroll
            for (int m = 0; m < 4; ++m) pp[ai][m] = *(const f32x4*)(rss + (size_t)(u.pm * BM + ai * HALF + wr * 64 + m * 16 + fr) * 16 + fq * 4);
        const float* bp = bias + (size_t)(u.pm >> 3) * NGU + u.pn * BM + wc * 32 + 8 * fq;
        bb[0] = *(const f32x4*)bp; bb[1] = *(const f32x4*)(bp + 4); bb[2] = *(const f32x4*)(bp + HALF); bb[3] = *(const f32x4*)(bp + HALF + 4);
    }
    __device__ __forceinline__ void park(int wr, int wc, int fr, int fq, const f32x4 (&pp)[2][4], const f32x4 (&bb)[4]) const {
        PG8_LAS float* sw = st + (wr * 4 + wc) * 192; float rs[2][4];
#pragma unroll
        for (int ai = 0; ai < 2; ++ai)
#pragma unroll
            for (int m = 0; m < 4; ++m) { const f32x4 p = pp[ai][m]; float s = (p[0] + p[1]) + (p[2] + p[3]); s += __shfl_xor(s, 16); s += __shfl_xor(s, 32); rs[ai][m] = rsqrtf(s * (1.0f / DM) + EPS); }
        if (fq == 0) { *(PG8_LAS f32x4*)(sw + fr * 8) = (f32x4){rs[0][0], rs[0][1], rs[0][2], rs[0][3]}; *(PG8_LAS f32x4*)(sw + fr * 8 + 4) = (f32x4){rs[1][0], rs[1][1], rs[1][2], rs[1][3]}; }
        if (fr == 0) {
#pragma unroll
            for (int q = 0; q < 4; ++q) *(PG8_LAS f32x4*)(sw + 128 + fq * 16 + 4 * q) = bb[q]; }
    }
    __device__ __forceinline__ void prime(const Unit& u, int wr, int wc, int fr, int fq) const { f32x4 pp[2][4], bb[4]; fetch(u, wr, wc, fr, fq, pp, bb); park(wr, wc, fr, fq, pp, bb); }
    __device__ __forceinline__ void operator()(const f32x4 (&acc)[2][2][4][2], const Unit& u, bool has_next, const Unit& nx, int wr, int wc, int fr, int fq) const {
        PG8_LAS float* sw = st + (wr * 4 + wc) * 192;
        const f32x4 r0 = *(const PG8_LAS f32x4*)(sw + fr * 8), r1 = *(const PG8_LAS f32x4*)(sw + fr * 8 + 4);
        const f32x4 ba0 = *(const PG8_LAS f32x4*)(sw + 128 + fq * 16), ba1 = *(const PG8_LAS f32x4*)(sw + 128 + fq * 16 + 4), bb0 = *(const PG8_LAS f32x4*)(sw + 128 + fq * 16 + 8), bb1 = *(const PG8_LAS f32x4*)(sw + 128 + fq * 16 + 12);
        f32x4 pp[2][4], nb[4];
        if (has_next) fetch(nx, wr, wc, fr, fq, pp, nb);
        const int hc = u.pn * HALF + wc * 32 + 8 * fq;
#pragma unroll
        for (int ai = 0; ai < 2; ++ai)
#pragma unroll
            for (int m = 0; m < 4; ++m) {
                const int row = u.pm * BM + ai * HALF + wr * 64 + m * 16 + fr; const float r = ai ? r1[m] : r0[m];
                const f32x4 a0 = acc[ai][0][m][0] * r + ba0, a1 = acc[ai][0][m][1] * r + ba1, b0 = acc[ai][1][m][0] * r + bb0, b1 = acc[ai][1][m][1] * r + bb1;
                f32x4 h0, h1;
#pragma unroll
                for (int i = 0; i < 4; ++i) { h0[i] = a0[i] * b0[i] * __builtin_amdgcn_rcpf(1.0f + __builtin_amdgcn_exp2f(-LOG2E * a0[i])); h1[i] = a1[i] * b1[i] * __builtin_amdgcn_rcpf(1.0f + __builtin_amdgcn_exp2f(-LOG2E * a1[i])); }
                *(u32x4*)(H + (size_t)row * DFF + hc) = pack8(h0, h1);
            }
        if (has_next) park(wr, wc, fr, fq, pp, nb);
    }
};

template <class Epi, class Sched, bool ALIGN_EPI = false, bool SP2 = false>
__device__ __forceinline__ void gemm_phase(PG8_LAS unsigned char* lds, const Gemm g, const Sched& S, const Epi& E, int tid_in) {
    int tid = tid_in; asm volatile("" : "+v"(tid));
    const int wid = __builtin_amdgcn_readfirstlane(tid >> 6), lane = tid & 63, wr = wid >> 2, wc = wid & 3, fr = lane & 15, fq = lane >> 4;
    const int K = g.K, nt = K / BK;
    unsigned voffA[2], voffB[2];
#pragma unroll
    for (int i = 0; i < 2; ++i) { int R, C; stage_rc(tid * 16 + i * 8192, R, C); const int Rb = Epi::PERM ? ((R & ~31) + perm32(R & 31)) : R;
        voffA[i] = (unsigned)(R * K + C) * 2u; voffB[i] = (unsigned)(Rb * K + C) * 2u; }
    const size_t kstep = (size_t)(BK * 2);
    const size_t hstep = (size_t)HALF * K * 2;
    const size_t tstep = 2 * hstep;
    const unsigned ldsw = (unsigned)wid * 1024u;
    const int aoff = lds_byte(wr * 64 + fr, fq * 8), boff = lds_byte(wc * 32 + fr, fq * 8);
#define PG8_SA(b, h) (((b) * 2 + (h)) * HTB)
#define PG8_SB(b, h) ((4 + (b) * 2 + (h)) * HTB)
#define PG8_STAGE(bufoff, gbase, voff) do { _Pragma("unroll") for (int _i = 0; _i < 2; ++_i) \
        __builtin_amdgcn_global_load_lds((const unsigned*)((const char*)(gbase) + (voff)[_i]), (PG8_LAS unsigned*)(lds + (bufoff) + ldsw + _i * 8192), 16, 0, 0); } while (0)
#define PG8_LDA(dst, b, h) do { _Pragma("unroll") for (int m = 0; m < 4; ++m) _Pragma("unroll") for (int k = 0; k < 2; ++k) dst[m][k] = *(const PG8_LAS bf16x8*)(lds + PG8_SA(b, h) + aoff + m * 2048 + k * 1024); } while (0)
#define PG8_LDB(dst, b, h) do { _Pragma("unroll") for (int n = 0; n < 2; ++n) _Pragma("unroll") for (int k = 0; k < 2; ++k) dst[n][k] = *(const PG8_LAS bf16x8*)(lds + PG8_SB(b, h) + boff + n * 2048 + k * 1024); } while (0)
#define PG8_MMA(ai, bj, At, Bt) do { __builtin_amdgcn_s_setprio(1); _Pragma("unroll") for (int m = 0; m < 4; ++m) _Pragma("unroll") for (int n = 0; n < 2; ++n) _Pragma("unroll") for (int k = 0; k < 2; ++k) \
        acc[ai][bj][m][n] = __builtin_amdgcn_mfma_f32_16x16x32_bf16(Bt[n][k], At[m][k], acc[ai][bj][m][n], 0, 0, 0); __builtin_amdgcn_s_setprio(0); } while (0)
#define PG8_WAIT_V(n) asm volatile("s_waitcnt vmcnt(" #n ")" ::: "memory")
#define PG8_WAIT_L(n) asm volatile("s_waitcnt lgkmcnt(" #n ")" ::: "memory")
#define PG8_BAR __builtin_amdgcn_s_barrier()
#define PG8_SCHED __builtin_amdgcn_sched_barrier(0)
    Unit cur, nxt; int ui = 0;
    if (!S.next(0, cur)) return;
    if constexpr (Epi::WANTS_NEXT) E.prime(cur, wr, wc, fr, fq);
    f32x4 acc[2][2][4][2];
#pragma unroll
    for (int a = 0; a < 2; ++a)
#pragma unroll
        for (int b = 0; b < 2; ++b)
#pragma unroll
            for (int m = 0; m < 4; ++m)
#pragma unroll
                for (int n = 0; n < 2; ++n) acc[a][b][m][n] = (f32x4){0.f, 0.f, 0.f, 0.f};
    bf16x8 At[4][2], B0[2][2], B1[2][2];
    const char* cA = (const char*)g.A + (size_t)cur.pm * tstep; const char* cB = (const char*)g.Bt + (size_t)cur.pn * tstep;
    S.a_ready(cur);
    if constexpr (SP2) {
        PG8_STAGE(PG8_SB(0, 0), cB, voffB); PG8_STAGE(PG8_SB(0, 1), cB + hstep, voffB); PG8_STAGE(PG8_SA(0, 0), cA, voffA); PG8_STAGE(PG8_SA(0, 1), cA + hstep, voffA);
        if (wr == 1) PG8_BAR;
        PG8_WAIT_V(2); PG8_BAR;
        PG8_STAGE(PG8_SB(1, 0), cB + kstep, voffB); PG8_STAGE(PG8_SA(1, 0), cA + kstep, voffA); PG8_STAGE(PG8_SB(1, 1), cB + hstep + kstep, voffB);
        PG8_WAIT_V(6); PG8_BAR;
    } else {
        PG8_STAGE(PG8_SB(0, 0), cB, voffB); PG8_STAGE(PG8_SA(0, 0), cA, voffA); PG8_STAGE(PG8_SB(0, 1), cB + hstep, voffB); PG8_STAGE(PG8_SA(0, 1), cA + hstep, voffA);
        if (wr == 1) PG8_BAR;
        PG8_WAIT_V(4); PG8_BAR;
        PG8_STAGE(PG8_SB(1, 0), cB + kstep, voffB); PG8_STAGE(PG8_SA(1, 0), cA + kstep, voffA); PG8_STAGE(PG8_SB(1, 1), cB + hstep + kstep, voffB);
        PG8_WAIT_V(6); PG8_BAR;
    }
    for (;;) {
        const bool has_next = S.next(ui + 1, nxt);
        const char* nA = has_next ? (const char*)g.A + (size_t)nxt.pm * tstep : cA; const char* nB = has_next ? (const char*)g.Bt + (size_t)nxt.pn * tstep : cB;
        for (int t = 0; t < nt; t += 2) {
            const bool last = (t == nt - 2);
            const char* a1 = cA + (size_t)(t + 1) * kstep;
            const char* a2 = last ? nA : cA + (size_t)(t + 2) * kstep; const char* b2 = last ? nB : cB + (size_t)(t + 2) * kstep;
            const char* a3 = a2 + kstep; const char* b3 = b2 + kstep;
            if (last && has_next) S.a_ready(nxt);
            if constexpr (SP2) {
            PG8_LDB(B0, 0, 0); PG8_LDB(B1, 0, 1); PG8_SCHED; PG8_LDA(At, 0, 0); PG8_STAGE(PG8_SA(1, 1), a1 + hstep, voffA);
            PG8_WAIT_V(8); PG8_WAIT_L(0); PG8_BAR; PG8_MMA(0, 0, At, B0); PG8_MMA(0, 1, At, B1); PG8_BAR; PG8_SCHED;
            PG8_LDA(At, 0, 1); PG8_STAGE(PG8_SB(0, 0), b2, voffB); PG8_STAGE(PG8_SB(0, 1), b2 + hstep, voffB); PG8_STAGE(PG8_SA(0, 0), a2, voffA);
            PG8_WAIT_V(8); PG8_WAIT_L(0); PG8_BAR; PG8_MMA(1, 0, At, B0); PG8_MMA(1, 1, At, B1); PG8_BAR; PG8_SCHED;
            PG8_LDB(B0, 1, 0); PG8_LDB(B1, 1, 1); PG8_SCHED; PG8_LDA(At, 1, 0); PG8_STAGE(PG8_SA(0, 1), a2 + hstep, voffA);
            PG8_WAIT_V(8); PG8_WAIT_L(0); PG8_BAR; PG8_MMA(0, 0, At, B0); PG8_MMA(0, 1, At, B1); PG8_BAR; PG8_SCHED;
            PG8_LDA(At, 1, 1); PG8_STAGE(PG8_SB(1, 0), b3, voffB); PG8_STAGE(PG8_SB(1, 1), b3 + hstep, voffB); PG8_STAGE(PG8_SA(1, 0), a3, voffA);
            PG8_WAIT_V(8); PG8_WAIT_L(0); PG8_BAR; PG8_MMA(1, 0, At, B0); PG8_MMA(1, 1, At, B1); PG8_BAR; PG8_SCHED;
            } else {
            PG8_LDB(B0, 0, 0); PG8_SCHED; PG8_LDA(At, 0, 0); PG8_STAGE(PG8_SA(1, 1), a1 + hstep, voffA);
            PG8_WAIT_L(8); PG8_BAR; PG8_WAIT_L(0); PG8_MMA(0, 0, At, B0); PG8_BAR; PG8_SCHED;
            PG8_LDB(B1, 0, 1); PG8_STAGE(PG8_SB(0, 0), b2, voffB);
            PG8_BAR; PG8_WAIT_L(0); PG8_MMA(0, 1, At, B1); PG8_BAR;
            PG8_LDA(At, 0, 1); PG8_STAGE(PG8_SA(0, 0), a2, voffA);
            PG8_BAR; PG8_WAIT_L(0); PG8_MMA(1, 0, At, B0); PG8_BAR; PG8_SCHED;
            PG8_STAGE(PG8_SB(0, 1), b2 + hstep, voffB);
            PG8_WAIT_V(6); PG8_BAR; PG8_MMA(1, 1, At, B1); PG8_BAR;
            PG8_LDB(B0, 1, 0); PG8_SCHED; PG8_LDA(At, 1, 0); PG8_STAGE(PG8_SA(0, 1), a2 + hstep, voffA);
            PG8_WAIT_L(8); PG8_BAR; PG8_WAIT_L(0); PG8_MMA(0, 0, At, B0); PG8_BAR; PG8_SCHED;
            PG8_LDB(B1, 1, 1); PG8_STAGE(PG8_SB(1, 0), b3, voffB);
            PG8_BAR; PG8_WAIT_L(0); PG8_MMA(0, 1, At, B1); PG8_BAR;
            PG8_LDA(At, 1, 1); PG8_STAGE(PG8_SA(1, 0), a3, voffA);
            PG8_BAR; PG8_WAIT_L(0); PG8_MMA(1, 0, At, B0); PG8_BAR; PG8_SCHED;
            PG8_STAGE(PG8_SB(1, 1), b3 + hstep, voffB);
            PG8_WAIT_V(6); PG8_BAR; PG8_MMA(1, 1, At, B1); PG8_BAR;
            }
        }
        if constexpr (ALIGN_EPI) { if (wr == 0) PG8_BAR; }
        if constexpr (!Epi::AFTER_DRAIN) { if constexpr (Epi::WANTS_NEXT) E(acc, cur, has_next, nxt, wr, wc, fr, fq); else E(acc, cur, wr, wc, fr, fq); S.done(cur); }
        if (!has_next) break;
#pragma unroll
        for (int a = 0; a < 2; ++a)
#pragma unroll
            for (int b = 0; b < 2; ++b)
#pragma unroll
                for (int m = 0; m < 4; ++m)
#pragma unroll
                    for (int n = 0; n < 2; ++n) acc[a][b][m][n] = (f32x4){0.f, 0.f, 0.f, 0.f};
        cur = nxt; cA = nA; cB = nB; ++ui;
        if constexpr (ALIGN_EPI) { if (wr == 1) PG8_BAR; }
    }
    PG8_WAIT_V(0);
    if constexpr (!ALIGN_EPI) { if (wr == 0) PG8_BAR; }
    PG8_BAR;
    if constexpr (Epi::AFTER_DRAIN) { E.fused(acc, cur, wr, wc, fr, fq, lds, wid, lane); S.done(cur); }
#undef PG8_SA
#undef PG8_SB
#undef PG8_STAGE
#undef PG8_LDA
#undef PG8_LDB
#undef PG8_MMA
#undef PG8_WAIT_V
#undef PG8_WAIT_L
#undef PG8_BAR
#undef PG8_SCHED
}
}

#define LAS __attribute__((address_space(3)))
#define XB_TMO      128
#define XB_XCNT(j)  (256  + 64 * (j))
#define XB_XSUB(j)  (1280 + 64 * (j))
#define XB_XGEN(j)  (2304 + 64 * (j))
#define XB_TOP      3328
#define XB_TOPGEN   3392
#define XCD_BAR_WORDS 3456
#define XB_SPIN_CAP (1u << 18)

__device__ __forceinline__ unsigned xb_ld(unsigned* p)              { return __hip_atomic_load(p, __ATOMIC_RELAXED, __HIP_MEMORY_SCOPE_AGENT); }
__device__ __forceinline__ unsigned xb_add(unsigned* p, unsigned v) { return __hip_atomic_fetch_add(p, v, __ATOMIC_RELAXED, __HIP_MEMORY_SCOPE_AGENT); }
__device__ __forceinline__ unsigned xb_xcc_id() { return (unsigned)__builtin_amdgcn_s_getreg((3 << 11) | 20) & 0xFu; }
#define XB_SPIN(cond, bar) do { unsigned _sp = 0; while (cond) { __builtin_amdgcn_s_sleep(1); \
    if ((++_sp & 255u) == 0u) { if (xb_ld(&(bar)[XB_TMO])) break; if (_sp > XB_SPIN_CAP) { atomicAdd(&(bar)[XB_TMO], 1u); break; } } } } while (0)

struct XcdBarrier {
    unsigned* bar; unsigned x;
    volatile LAS unsigned* st;
};

__device__ __forceinline__ XcdBarrier xcd_barrier_post(unsigned* bar, volatile LAS unsigned* st) {
    XcdBarrier b; b.bar = bar; b.x = xb_xcc_id(); b.st = st;
    if (threadIdx.x == 0) (void)xb_add(&bar[XB_XCNT(b.x)], 1u);
    return b;
}
__device__ __forceinline__ void xcd_barrier_complete(unsigned* bar, unsigned x, unsigned& nloc, unsigned& nx) {
    const unsigned G = gridDim.x * gridDim.y * gridDim.z;
    unsigned sum, cnt, mine, sp = 0u;
    for (;;) {
        sum = 0u; cnt = 0u; mine = 0u;
#pragma unroll
        for (unsigned j = 0; j < 16; ++j) { const unsigned c = xb_ld(&bar[XB_XCNT(j)]); sum += c; cnt += (c > 0u) ? 1u : 0u; mine = (j == x) ? c : mine; }
        if (sum == G) break;
        __builtin_amdgcn_s_sleep(1);
        if ((++sp & 255u) == 0u) { if (xb_ld(&bar[XB_TMO])) break; if (sp > XB_SPIN_CAP) { atomicAdd(&bar[XB_TMO], 1u); break; } }
    }
    nloc = mine > 0u ? mine : 1u; nx = cnt > 0u ? cnt : 1u;
}

__device__ __forceinline__ void xcd_barrier(const XcdBarrier& b) {
    asm volatile("s_waitcnt vmcnt(0)" ::: "memory");
    __syncthreads();
    if (threadIdx.x == 0) {
        unsigned* bar = b.bar;
        __builtin_amdgcn_s_waitcnt(0);
        unsigned nloc = b.st[0], nx = b.st[1];
        if (nloc == 0u) { xcd_barrier_complete(bar, b.x, nloc, nx); b.st[0] = nloc; b.st[1] = nx; }
        const unsigned old = xb_add(&bar[XB_XSUB(b.x)], 1u);
        const unsigned gen = old / nloc;
        if (old + 1u == (gen + 1u) * nloc) {
            __builtin_amdgcn_fence(__ATOMIC_RELEASE, "agent");
            asm volatile("s_waitcnt vmcnt(0)" ::: "memory");
            const unsigned og = xb_add(&bar[XB_TOP], 1u);
            const unsigned tg = og / nx;
            if (og + 1u == (tg + 1u) * nx) xb_add(&bar[XB_TOPGEN], 1u);
            else XB_SPIN(xb_ld(&bar[XB_TOPGEN]) == tg, bar);
            __builtin_amdgcn_fence(__ATOMIC_ACQUIRE, "agent");
            xb_add(&bar[XB_XGEN(b.x)], 1u);
            asm volatile("s_waitcnt vmcnt(0)" ::: "memory");
        } else {
            XB_SPIN(xb_ld(&bar[XB_XGEN(b.x)]) == gen, bar);
            __builtin_amdgcn_fence(__ATOMIC_ACQUIRE, "agent");
            asm volatile("s_waitcnt vmcnt(0)" ::: "memory");
        }
    }
    __syncthreads();
}


typedef unsigned short bf16;
typedef unsigned u32x4 __attribute__((ext_vector_type(4)));
typedef unsigned u32x2 __attribute__((ext_vector_type(2)));
typedef float f32x4 __attribute__((ext_vector_type(4)));
typedef float f32x16 __attribute__((ext_vector_type(16)));
typedef short bf16x8 __attribute__((ext_vector_type(8)));
typedef short s16x4 __attribute__((ext_vector_type(4)));
using pg8::cvtpk; using pg8::pack8;

struct Args {
    const float *x_prompt, *x_sample, *cache_pool, *cache_k, *cache_v, *c_prompt, *c_sample, *w_ada, *b_ada, *g_mix, *w_in, *pool_w, *pool_scale, *sinks, *w_out, *g_ffn, *w_gate_up, *w_down, *g_final;
    float* out; unsigned char* ws;
};

__device__ __forceinline__ float wave_sum(float v) {
#pragma unroll
    for (int o = 1; o < 64; o <<= 1) v += __shfl_xor(v, o);
    return v;
}
__device__ __forceinline__ int crow(int r, int hi) { return (r & 3) + 8 * (r >> 2) + 4 * hi; }
__device__ __forceinline__ float bf_lo(unsigned w) { return __uint_as_float(w << 16); }
__device__ __forceinline__ float bf_hi(unsigned w) { return __uint_as_float(w & 0xffff0000u); }
__device__ __forceinline__ float silu_f(float v) { return v * __builtin_amdgcn_rcpf(1.0f + __builtin_amdgcn_exp2f(-LOG2E * v)); }

__device__ __forceinline__ void transpose_item(const float* W, int ldw, bf16* WT, int ldt, int out_row0, int out_col0, LAS float* scr, int lane) {
    f32x4 v[16];
#pragma unroll
    for (int i = 0; i < 16; ++i) v[i] = *(const f32x4*)(W + (size_t)(4 * i + (lane >> 4)) * ldw + 4 * (lane & 15));
    const int c = lane & 7;
#pragma unroll
    for (int p = 0; p < 2; ++p) {
        if (((lane & 15) >> 3) == p) {
#pragma unroll
            for (int i = 0; i < 16; ++i) { LAS float* s = scr + (4 * i + (lane >> 4)) * 33 + 4 * (lane & 7); s[0] = v[i][0]; s[1] = v[i][1]; s[2] = v[i][2]; s[3] = v[i][3]; } }
        asm volatile("s_waitcnt lgkmcnt(0)" ::: "memory");
#pragma unroll
        for (int j = 0; j < 4; ++j) { const int n = (lane >> 3) + 8 * j; const LAS float* s = scr + (8 * c) * 33 + n;
            u32x4 o; o.x = cvtpk(s[0 * 33], s[1 * 33]); o.y = cvtpk(s[2 * 33], s[3 * 33]); o.z = cvtpk(s[4 * 33], s[5 * 33]); o.w = cvtpk(s[6 * 33], s[7 * 33]);
            *(u32x4*)(WT + (size_t)(out_row0 + 32 * p + n) * ldt + out_col0 + 8 * c) = o; }
        asm volatile("s_waitcnt lgkmcnt(0)" ::: "memory");
    }
}
__device__ __forceinline__ int grab(LAS unsigned* ctr, int lane) { unsigned v = 0u; if (lane == 0) v = __hip_atomic_fetch_add(ctr, 1u, __ATOMIC_RELAXED, __HIP_MEMORY_SCOPE_WORKGROUP); return (int)__builtin_amdgcn_readfirstlane(v) * (int)gridDim.x + (int)blockIdx.x; }

#define MFMA_BF(a, b, c) __builtin_amdgcn_mfma_f32_32x32x16_bf16((a), (b), (c), 0, 0, 0)
#define MFMA_F32(a, b, c) __builtin_amdgcn_mfma_f32_32x32x2f32((a), (b), (c), 0, 0, 0)
template <class LA, class LB>
__device__ __forceinline__ void sgemm64_1(int kb, int ke, const LA& la, const LB& lb, f32x16& c0, f32x16& c1, int lane) {
    const int r = lane & 31, h = lane >> 5;
#pragma unroll
    for (int i = 0; i < 16; ++i) { c0[i] = 0.f; c1[i] = 0.f; }
    f32x4 a0[4], a1[4], p0[4], p1[4]; float b[4][4], q[4][4];
#define SG_LOAD(A0, A1, B, kk) do { _Pragma("unroll") for (int u = 0; u < 4; ++u) { const int k = (kk) + 8 * u + 4 * h; A0[u] = la(0, r, k); A1[u] = la(1, r, k); _Pragma("unroll") for (int j = 0; j < 4; ++j) B[u][j] = lb(k + j, r); } } while (0)
#define SG_MMA(A0, A1, B) do { _Pragma("unroll") for (int u = 0; u < 4; ++u) _Pragma("unroll") for (int j = 0; j < 4; ++j) { c0 = MFMA_F32(A0[u][j], B[u][j], c0); c1 = MFMA_F32(A1[u][j], B[u][j], c1); } } while (0)
    SG_LOAD(a0, a1, b, kb);
    for (int k0 = kb; k0 < ke; k0 += 64) {
        SG_LOAD(p0, p1, q, k0 + 32);
        SG_MMA(a0, a1, b);
        if (k0 + 64 < ke) SG_LOAD(a0, a1, b, k0 + 64);
        SG_MMA(p0, p1, q);
    }
#undef SG_LOAD
#undef SG_MMA
}
template <int NB, class LA, class LB>
__device__ __forceinline__ void sgemm64(int kb, int ke, const LA& la, const LB& lb, f32x16 (&c)[NB][2], int lane) {
    constexpr int SUB = NB == 1 ? 4 : 2;
    const int r = lane & 31, h = lane >> 5;
#pragma unroll
    for (int nb = 0; nb < NB; ++nb)
#pragma unroll
        for (int i = 0; i < 16; ++i) { c[nb][0][i] = 0.f; c[nb][1][i] = 0.f; }
    f32x4 a0[SUB], a1[SUB], p0[SUB], p1[SUB]; float b[NB][SUB][4], q[NB][SUB][4];
#define SG_LOAD(A0, A1, B, kk) do { _Pragma("unroll") for (int u = 0; u < SUB; ++u) { const int k = (kk) + 8 * u + 4 * h; A0[u] = la(0, r, k); A1[u] = la(1, r, k); _Pragma("unroll") for (int nb = 0; nb < NB; ++nb) _Pragma("unroll") for (int j = 0; j < 4; ++j) B[nb][u][j] = lb(k + j, r + 32 * nb); } } while (0)
#define SG_MMA(A0, A1, B) do { _Pragma("unroll") for (int u = 0; u < SUB; ++u) _Pragma("unroll") for (int j = 0; j < 4; ++j) _Pragma("unroll") for (int nb = 0; nb < NB; ++nb) { c[nb][0] = MFMA_F32(A0[u][j], B[nb][u][j], c[nb][0]); c[nb][1] = MFMA_F32(A1[u][j], B[nb][u][j], c[nb][1]); } } while (0)
    SG_LOAD(a0, a1, b, kb);
    for (int k0 = kb; k0 < ke; k0 += 16 * SUB) {
        SG_LOAD(p0, p1, q, k0 + 8 * SUB);
        SG_MMA(a0, a1, b);
        if (k0 + 16 * SUB < ke) SG_LOAD(a0, a1, b, k0 + 16 * SUB);
        SG_MMA(p0, p1, q);
    }
#undef SG_LOAD
#undef SG_MMA
}
template <class LA, class LB>
__device__ __forceinline__ void wg_sgemm64x2(LAS unsigned char* lds, int K, const LA& la, const LB& lb, float* out, int ld, const float* addp, int lane, int wave) {
    f32x16 c[2][2]; sgemm64<2>(wave * (K >> 3), (wave + 1) * (K >> 3), la, lb, c, lane);
    LAS float* red = (LAS float*)lds;
#pragma unroll
    for (int nb = 0; nb < 2; ++nb)
#pragma unroll
        for (int blk = 0; blk < 2; ++blk)
#pragma unroll
            for (int i = 0; i < 16; ++i) red[(wave * 64 + nb * 32 + blk * 16 + i) * 64 + lane] = c[nb][blk][i];
    __syncthreads();
    const int h = lane >> 5;
#pragma unroll
    for (int j = 0; j < 8; ++j) { const int i = 8 * wave + j, nb = i >> 5, blk = (i >> 4) & 1, reg = i & 15; float s = 0.f;
#pragma unroll
        for (int p = 0; p < 8; ++p) s += red[(p * 64 + i) * 64 + lane];
        const int col = 32 * nb + (lane & 31); out[(size_t)(32 * blk + crow(reg, h)) * ld + col] = s + (addp ? addp[col] : 0.f); }
    __syncthreads();
}
struct LA_silu { const float* cp; const float* cs; __device__ __forceinline__ f32x4 operator()(int blk, int r, int k) const { const f32x4 v = *(const f32x4*)((blk ? cs : cp) + (size_t)r * DM + k); return (f32x4){silu_f(v[0]), silu_f(v[1]), silu_f(v[2]), silu_f(v[3])}; } };
struct LA_rows { const float* A; int lda; __device__ __forceinline__ f32x4 operator()(int blk, int r, int k) const { return *(const f32x4*)(A + (size_t)(32 * blk + r) * lda + k); } };
struct LB_plain { const float* B; int ldb; __device__ __forceinline__ float operator()(int k, int r) const { return B[(size_t)k * ldb + r]; } };
struct LB_scaled { const float* B; int ldb; const float* s; __device__ __forceinline__ float operator()(int k, int r) const { return B[(size_t)k * ldb + r] * s[k]; } };

__device__ __forceinline__ void phase0a(const Args& a, LAS unsigned char* lds, int tid, int lane, int wave, int cw = 16) {
    const int gw = blockIdx.x * 8 + wave, NGW = gridDim.x * 8, r = lane & 31, h = lane >> 5;
    LAS float* scr = (LAS float*)(lds + wave * 16384);
    float* mod = (float*)(a.ws + WS_MOD);
    bf16 *WinT = (bf16*)(a.ws + WS_WIN), *WoT = (bf16*)(a.ws + WS_WO), *WguT = (bf16*)(a.ws + WS_WGU), *WdT = (bf16*)(a.ws + WS_WD);
    constexpr int I_MOD = DEPTH * (6 * DM / 64), I_FOLD = DEPTH * 4 * 2 * (DM / 32);
    constexpr int T_IN = (DM / 64) * (INW / 64), T_OB = (512 / 64) * (DM / 64), T_GU = (DM / 64) * (NGU / 64), T_D = (DFF / 64) * (DM / 64), T_L = T_IN + T_OB + T_GU + T_D;
    constexpr int NITEMS = I_MOD + I_FOLD + DEPTH * T_L;
    for (int q = blockIdx.x; q < I_MOD; q += gridDim.x) {
        const int l = q / (6 * DM / 64), n0 = (q % (6 * DM / 64)) * 64;
        wg_sgemm64x2(lds, DM, LA_silu{a.c_prompt, a.c_sample}, LB_plain{a.w_ada + (size_t)l * DM * 6 * DM + n0, 6 * DM}, mod + (size_t)l * NSEQ * 6 * DM + n0, 6 * DM, a.b_ada + l * 6 * DM + n0, lane, wave);
    }
    LAS unsigned* ctr = (LAS unsigned*)(lds + XB_LDS_OFF) + cw;
    for (int it = grab(ctr, lane); it < NITEMS - I_MOD; it = grab(ctr, lane)) {
        int q = it; int ln = lane; asm volatile("" : "+v"(ln));
        if (q < I_FOLD) {
            const int nb = q % (DM / 32), half = (q / (DM / 32)) & 1, g = (q / (2 * DM / 32)) & 3, l = q / (8 * DM / 32), n0 = nb * 32;
            f32x16 c0, c1; sgemm64_1(0, 128, LA_rows{a.pool_w + ((size_t)(l * 4 + g) * 128 + half * 64) * 128, 128}, LB_scaled{a.w_out + ((size_t)l * DM + g * 128) * DM + n0, DM, a.pool_scale + l * PW + g * 128}, c0, c1, lane);
            bf16* wo = WoT + ((size_t)l * DM + n0 + r) * DM + g * 128 + half * 64 + 4 * h;
#pragma unroll
            for (int ig = 0; ig < 4; ++ig) { u32x2 w0, w1; w0.x = cvtpk(c0[4 * ig], c0[4 * ig + 1]); w0.y = cvtpk(c0[4 * ig + 2], c0[4 * ig + 3]); w1.x = cvtpk(c1[4 * ig], c1[4 * ig + 1]); w1.y = cvtpk(c1[4 * ig + 2], c1[4 * ig + 3]);
                *(u32x2*)(wo + 8 * ig) = w0; *(u32x2*)(wo + 32 + 8 * ig) = w1; }
            continue; }
        q -= I_FOLD;
        const int l = q / T_L; q -= l * T_L;
        if (q < T_IN) { const int kb = q / (INW / 64), nb = q % (INW / 64); transpose_item(a.w_in + ((size_t)l * DM + 64 * kb) * INW + 64 * nb, INW, WinT + (size_t)l * INW * DM, DM, 64 * nb, 64 * kb, scr, ln); continue; }
        q -= T_IN;
        if (q < T_OB) { const int kb = q / (DM / 64), nb = q % (DM / 64); transpose_item(a.w_out + ((size_t)l * DM + 512 + 64 * kb) * DM + 64 * nb, DM, WoT + (size_t)l * DM * DM, DM, 64 * nb, 512 + 64 * kb, scr, ln); continue; }
        q -= T_OB;
        if (q < T_GU) { const int kb = q / (NGU / 64), nb = q % (NGU / 64), o = 64 * nb, bj = o / DFF, rem = o - bj * DFF, orow = (rem >> 7) * 256 + bj * 128 + (rem & 127);
            transpose_item(a.w_gate_up + ((size_t)l * DM + 64 * kb) * NGU + o, NGU, WguT + (size_t)l * NGU * DM, DM, orow, 64 * kb, scr, ln); continue; }
        q -= T_GU;
        { const int kb = q / (DM / 64), nb = q % (DM / 64); transpose_item(a.w_down + ((size_t)l * DFF + 64 * kb) * DM + 64 * nb, DM, WdT + (size_t)l * DM * DFF, DFF, 64 * nb, 64 * kb, scr, ln); }
    }
    constexpr int CP4 = (WIN - DSEQ) * KVW / 4, NCP = DEPTH * 32 * 2 * CP4;
    for (int i = blockIdx.x * 512 + tid; i < NCP; i += gridDim.x * 512) {
        const int e = i % CP4, lb2 = i / CP4, kv = lb2 & 1, lb = lb2 >> 1;
        const f32x4 v = *(const f32x4*)((kv ? a.cache_v : a.cache_k) + ((size_t)lb * WIN + DSEQ) * KVW + 4 * e);
        *(f32x4*)(a.out + (kv ? O_VS : O_KS) + (size_t)lb * WIN * KVW + 4 * e) = v;
    }
}

__device__ __forceinline__ void phase0b(const Args& a, LAS unsigned char* lds, int tid, int lane, int wave, int cw = 17) {
    const int gw = blockIdx.x * 8 + wave, NGW = gridDim.x * 8, r = lane & 31, h = lane >> 5;
    const float* mod = (const float*)(a.ws + WS_MOD);
    float *bin = (float*)(a.ws + WS_BIN), *bgu = (float*)(a.ws + WS_BGU);
    constexpr int I_BIN = DEPTH * (INW / 32), I_BGU = DEPTH * (NGU / 32);
    bf16* XN = (bf16*)(a.ws + WS_XN); float* rss = (float*)(a.ws + WS_RSS);
    LAS unsigned* ctr = (LAS unsigned*)(lds + XB_LDS_OFF) + cw;
    constexpr int RCH = 8, I_ROWS = MT / RCH;
    for (int it = grab(ctr, lane); it < I_BIN + I_BGU + I_ROWS; it = grab(ctr, lane)) {
        if (it < I_BIN + I_BGU) {
            const bool gu = it >= I_BIN; const int q = gu ? it - I_BIN : it, NW = gu ? NGU : INW, l = q / (NW / 32), n0 = (q % (NW / 32)) * 32;
            const bf16* wp = (const bf16*)(a.ws + (gu ? WS_WGU : WS_WIN)) + ((size_t)l * NW + n0 + r) * DM + 8 * h;
            const float* sp = mod + ((size_t)l * NSEQ + r) * 6 * DM + (gu ? 3 * DM : 0) + 8 * h;
            f32x16 c0, c1;
#pragma unroll
            for (int i = 0; i < 16; ++i) { c0[i] = 0.f; c1[i] = 0.f; }
#pragma unroll 4
            for (int kk = 0; kk < DM; kk += 16) {
                const bf16x8 w = *(const bf16x8*)(wp + kk);
#pragma unroll
                for (int blk = 0; blk < 2; ++blk) { const float* s = sp + (size_t)blk * 32 * 6 * DM + kk; const f32x4 s0 = *(const f32x4*)s, s1 = *(const f32x4*)(s + 4);
                    const u32x4 hi = pack8(s0, s1); f32x4 h0, h1; pg8::unpack8(hi, h0, h1); const u32x4 lo = pack8(s0 - h0, s1 - h1);
                    if (blk == 0) { c0 = MFMA_BF(w, __builtin_bit_cast(bf16x8, hi), c0); c0 = MFMA_BF(w, __builtin_bit_cast(bf16x8, lo), c0); }
                    else { c1 = MFMA_BF(w, __builtin_bit_cast(bf16x8, hi), c1); c1 = MFMA_BF(w, __builtin_bit_cast(bf16x8, lo), c1); } }
            }
            float* ob = (gu ? bgu : bin) + ((size_t)l * NSEQ + r) * NW + n0 + 4 * h;
#pragma unroll
            for (int ig = 0; ig < 4; ++ig) { *(f32x4*)(ob + 8 * ig) = (f32x4){c0[4 * ig], c0[4 * ig + 1], c0[4 * ig + 2], c0[4 * ig + 3]}; *(f32x4*)(ob + (size_t)32 * NW + 8 * ig) = (f32x4){c1[4 * ig], c1[4 * ig + 1], c1[4 * ig + 2], c1[4 * ig + 3]}; }
            continue;
        }
        {
            const int row0 = (it - I_BIN - I_BGU) * RCH;
            f32x4 gm[4];
#pragma unroll
            for (int j = 0; j < 4; ++j) gm[j] = *(const f32x4*)(a.g_mix + 4 * (lane + 64 * j));
#pragma unroll
            for (int rb = 0; rb < RCH; rb += 4) {
                f32x4 v[4][4];
#pragma unroll
                for (int rr = 0; rr < 4; ++rr) { const int row = row0 + rb + rr; const float* xr = row < MP ? a.x_prompt + (size_t)row * DM : a.x_sample + (size_t)(row - MP) * DM;
#pragma unroll
                    for (int j = 0; j < 4; ++j) v[rr][j] = *(const f32x4*)(xr + 4 * (lane + 64 * j)); }
#pragma unroll
                for (int rr = 0; rr < 4; ++rr) { const int row = row0 + rb + rr; const float* sc = mod + (size_t)pg8::row_seq(row) * 6 * DM + DM; float s = 0.f;
#pragma unroll
                    for (int j = 0; j < 4; ++j) s += (v[rr][j][0] * v[rr][j][0] + v[rr][j][1] * v[rr][j][1]) + (v[rr][j][2] * v[rr][j][2] + v[rr][j][3] * v[rr][j][3]);
                    s = wave_sum(s);
#pragma unroll
                    for (int j = 0; j < 4; ++j) { const int c = 4 * (lane + 64 * j); const f32x4 o = v[rr][j] * pg8::gm4(gm[j], *(const f32x4*)(sc + c));
                        u32x2 w; w.x = cvtpk(o[0], o[1]); w.y = cvtpk(o[2], o[3]); *(u32x2*)(XN + (size_t)row * DM + c) = w;
                    }
                    if (lane < 16) rss[(size_t)row * 16 + lane] = lane == 0 ? s : 0.f; }
            }
        }
    }
}

__device__ __forceinline__ void ld8(float (&o)[8], const bf16* p) { const u32x4 w = *(const u32x4*)p; o[0] = bf_lo(w.x); o[1] = bf_hi(w.x); o[2] = bf_lo(w.y); o[3] = bf_hi(w.y); o[4] = bf_lo(w.z); o[5] = bf_hi(w.z); o[6] = bf_lo(w.w); o[7] = bf_hi(w.w); }
__device__ __forceinline__ void pool_get(float (&o)[8], bool samp, int b, int t, int ch0, const bf16* U, const float* cpool) {
    if (t < 0) {
        if (samp) { const float* p = cpool + ((size_t)b * PH + (PH + t)) * PW + ch0; const f32x4 x = *(const f32x4*)p, y = *(const f32x4*)(p + 4); o[0] = x[0]; o[1] = x[1]; o[2] = x[2]; o[3] = x[3]; o[4] = y[0]; o[5] = y[1]; o[6] = y[2]; o[7] = y[3]; }
        else {
#pragma unroll
            for (int i = 0; i < 8; ++i) o[i] = 0.f; }
    } else ld8(o, U + ((size_t)(samp ? MP + b * DSEQ + t : b * SEQ + t)) * PW + ch0);
}
__device__ __forceinline__ void pool_phase(const Args& a, int l, int lane, int wave) {
    const int gw = blockIdx.x * 8 + wave, NGW = gridDim.x * 8;
    const bf16* U = (const bf16*)(a.ws + WS_U); bf16* MIX = (bf16*)(a.ws + WS_MIX);
    const float* cpool = a.cache_pool + (size_t)l * 32 * PH * PW;
    constexpr int NPB = MP / 16;
    for (int it = gw; it < 2 * (NPB + NBS); it += NGW) {
        const int hf = it & 1, blk = it >> 1; const bool samp = blk >= NPB;
        const int b = samp ? blk - NPB : blk >> 7, t0 = samp ? 0 : (blk & 127) * 16;
        const int ch = hf * 256 + lane * 4, wl = 1 + 2 * hf + (lane >> 5), w = 1 << wl;
        const size_t rowbase = samp ? (size_t)MP + b * DSEQ : (size_t)b * SEQ + t0;
        f32x4 S[31]; u32x2 raw[31];
#pragma unroll
        for (int i = 0; i < 31; ++i) {
            raw[i] = (u32x2){0u, 0u};
            if (samp && i < 15) S[i] = *(const f32x4*)(cpool + ((size_t)b * PH + i) * PW + ch);
            else if (samp || t0 - 15 + i >= 0) raw[i] = *(const u32x2*)(U + (rowbase + i - 15) * PW + ch);
        }
#pragma unroll
        for (int i = 0; i < 31; ++i) if (!(samp && i < 15)) S[i] = (f32x4){bf_lo(raw[i].x), bf_hi(raw[i].x), bf_lo(raw[i].y), bf_hi(raw[i].y)};
        f32x4 cur[16];
#pragma unroll
        for (int j = 0; j < 16; ++j) cur[j] = S[15 + j];
#pragma unroll
        for (int i = 30; i >= 1; --i) S[i] += S[i - 1];
        if (wl >= 2) {
#pragma unroll
            for (int i = 30; i >= 2; --i) S[i] += S[i - 2]; }
        if (wl >= 3) {
#pragma unroll
            for (int i = 30; i >= 4; --i) S[i] += S[i - 4]; }
        if (wl >= 4) {
#pragma unroll
            for (int i = 30; i >= 8; --i) S[i] += S[i - 8]; }
#pragma unroll
        for (int j = 0; j < 16; ++j) {
            const int t = t0 + j; const float inv = 1.0f / (float)((samp || t + 1 >= w) ? w : t + 1);
            const f32x4 d = S[15 + j] * inv - cur[j];
            u32x2 o; o.x = cvtpk(d[0], d[1]); o.y = cvtpk(d[2], d[3]);
            *(u32x2*)(MIX + (rowbase + j) * DM + ch) = o;
        }
    }
}

constexpr int KS_STRIDE = 144, VT_STRIDE = 408  , LDS_KS = 0, LDS_VT = 192 * KS_STRIDE;
__device__ __forceinline__ int mk_tid(int wave);
struct AttnPre { u32x4 k[3], va[2], vb[2]; };
__device__ __forceinline__ void attn_decode(int unit, bool& samp, int& b, int& c, int& hkv, int& lo, int& hi) {
    samp = unit < 2 * NBS; c = 0;
    if (samp) { b = unit >> 1; hkv = unit & 1; } else { const int u2 = unit - 2 * NBS; hkv = u2 & 1; c = (u2 >> 1) & 31; b = u2 >> 6; }
    lo = samp ? 0 : (c >= 2 ? 0 : (2 - c) * 64); hi = samp ? WIN + DSEQ : 192;
}
__device__ __forceinline__ void attn_fetch(const Args& a, int l, int unit, int tid, AttnPre& P) {
    const bf16 *Kb = (const bf16*)(a.ws + WS_K), *Vb = (const bf16*)(a.ws + WS_V);
    bool samp; int b, c, hkv, lo, hi; attn_decode(unit, samp, b, c, hkv, lo, hi);
    const u32x4 z4 = {0u, 0u, 0u, 0u};
#pragma unroll
    for (int i = 0; i < 3; ++i) { const int p = tid + 512 * i, slot = p >> 3, ch = p & 7; u32x4 val = z4;
        if (slot >= lo && slot < hi) {
            if (samp && slot < WIN) { const float* s = a.cache_k + ((((size_t)l * 32 + b) * WIN + slot) * 2 + hkv) * 64 + ch * 8; val = pack8(*(const f32x4*)s, *(const f32x4*)(s + 4)); }
            else { const size_t grow = samp ? (size_t)MP + b * DSEQ + (slot - WIN) : (size_t)b * SEQ + (c - 2) * 64 + slot; val = *(const u32x4*)(Kb + grow * KVW + hkv * 64 + ch * 8); } }
        P.k[i] = val; }
#pragma unroll
    for (int i = 0; i < 2; ++i) { const int p = tid + 512 * i, jp = p >> 3, ch = p & 7, slot = 2 * jp; u32x4 va = z4, vb = z4;
        if (p < 96 * 8 && slot >= lo && slot < hi) {
            if (samp && slot < WIN) { const float* s = a.cache_v + ((((size_t)l * 32 + b) * WIN + slot) * 2 + hkv) * 64 + ch * 8; va = pack8(*(const f32x4*)s, *(const f32x4*)(s + 4)); vb = pack8(*(const f32x4*)(s + 128), *(const f32x4*)(s + 132)); }
            else { const size_t grow = samp ? (size_t)MP + b * DSEQ + (slot - WIN) : (size_t)b * SEQ + (c - 2) * 64 + slot; const bf16* s = Vb + grow * KVW + hkv * 64 + ch * 8; va = *(const u32x4*)s; vb = *(const u32x4*)(s + KVW); } }
        P.va[i] = va; P.vb[i] = vb; }
}
__device__ __forceinline__ void attn_stage(LAS unsigned char* lds, int tid, const AttnPre& P) {
#pragma unroll
    for (int i = 0; i < 3; ++i) { const int p = tid + 512 * i, slot = p >> 3, ch = p & 7; *(LAS u32x4*)(lds + LDS_KS + slot * KS_STRIDE + ch * 16) = P.k[i]; }
#pragma unroll
    for (int i = 0; i < 2; ++i) { const int p = tid + 512 * i, jp = p >> 3, ch = p & 7;
        if (p < 96 * 8) { LAS unsigned* vt = (LAS unsigned*)(lds + LDS_VT + (ch * 8) * VT_STRIDE + jp * 4);
#pragma unroll
            for (int j = 0; j < 4; ++j) { const unsigned wa = P.va[i][j], wb = P.vb[i][j];
                vt[(2 * j) * (VT_STRIDE / 4)] = (wa & 0xffffu) | (wb << 16); vt[(2 * j + 1) * (VT_STRIDE / 4)] = (wa >> 16) | (wb & 0xffff0000u); } } }
}
__device__ __forceinline__ void attn_qload(const Args& a, int unit, int lane, int wave, bf16x8 (&q)[4]) {
    const bf16* Qb = (const bf16*)(a.ws + WS_Q);
    bool samp; int b, c, hkv, lo, hi; attn_decode(unit, samp, b, c, hkv, lo, hi);
    const int g = wave >> 1, th = wave & 1, r32 = lane & 31, h = lane >> 5, tok = 32 * th + r32; const bool rv = !samp || tok < DSEQ;
    const size_t qrow = samp ? (size_t)MP + b * DSEQ + (rv ? tok : 0) : (size_t)b * SEQ + c * 64 + tok;
    const u32x4 z4 = {0u, 0u, 0u, 0u};
#pragma unroll
    for (int d0 = 0; d0 < 4; ++d0) { u32x4 q4 = z4; if (rv) q4 = *(const u32x4*)(Qb + qrow * AW + (hkv * 4 + g) * 64 + d0 * 16 + h * 8); q[d0] = __builtin_bit_cast(bf16x8, q4); }
}
__device__ __forceinline__ void attn_phase(const Args& a, LAS unsigned char* lds0, int l, int bx, int G, int wave) {
    constexpr int NU = 2 * NBS + NBP * 32 * 2, BUFB = 55296;
    const bf16* Qb = (const bf16*)(a.ws + WS_Q); bf16* MIX = (bf16*)(a.ws + WS_MIX);
    bf16x8 qr[4];
    if (bx < NU) { const int t = mk_tid(wave); AttnPre P; attn_fetch(a, l, bx, t, P); attn_qload(a, bx, t & 63, wave, qr); attn_stage(lds0, t, P); }
    __syncthreads();
    int buf = 0;
    for (int unit = bx; unit < NU; unit += G, buf ^= 1) {
        int tid = mk_tid(wave); asm volatile("" : "+v"(tid)); const int lane = tid & 63;
        LAS unsigned char* lds = lds0 + buf * BUFB;
        bool samp; int b, c, hkv, lo, hi; attn_decode(unit, samp, b, c, hkv, lo, hi);
        const u32x4 z4 = {0u, 0u, 0u, 0u};
        const int g = wave >> 1, th = wave & 1, r32 = lane & 31, h = lane >> 5;
    const int tok = 32 * th + r32; const bool rv = !samp || tok < DSEQ;
    const size_t qrow = samp ? (size_t)MP + b * DSEQ + (rv ? tok : 0) : (size_t)b * SEQ + c * 64 + tok;
    const int head = hkv * 4 + g;
        const bool active = !(samp && th == 1);
        AttnPre P; const bool more = unit + G < NU;
        if (active) {
        bf16x8 qn[4];
        if (more) { attn_fetch(a, l, unit + G, tid, P); attn_qload(a, unit + G, lane, wave, qn); }
    f32x16 s[6];
#pragma unroll
    for (int blk = 0; blk < 6; ++blk) {
#pragma unroll
        for (int i = 0; i < 16; ++i) s[blk][i] = 0.f;
#pragma unroll
        for (int d0 = 0; d0 < 4; ++d0) { const bf16x8 kf = *(const LAS bf16x8*)(lds + LDS_KS + (32 * blk + r32) * KS_STRIDE + d0 * 32 + h * 16); s[blk] = MFMA_BF(kf, qr[d0], s[blk]); }
        __builtin_amdgcn_sched_barrier(0);
    }
    const float sink2 = a.sinks[l * 8 + head] * LOG2E;
    if (lo > 0 || hi < 192) {
#pragma unroll
        for (int blk = 0; blk < 6; ++blk)
#pragma unroll
            for (int i = 0; i < 16; ++i) { const int slot = 32 * blk + crow(i, h); if (slot < lo || slot >= hi) s[blk][i] = -INFINITY; }
    }
    float mx = sink2;
#pragma unroll
    for (int blk = 0; blk < 6; ++blk)
#pragma unroll
        for (int i = 0; i < 16; ++i) mx = fmaxf(mx, s[blk][i]);
    mx = fmaxf(mx, __shfl_xor(mx, 32));
    float sum = 0.f; f32x4 sum4 = {0.f, 0.f, 0.f, 0.f}; u32x4 pk[12];
#pragma unroll
    for (int blk = 0; blk < 6; ++blk) {
        s[blk] = s[blk] - mx;
#pragma unroll
        for (int i = 0; i < 16; ++i) s[blk][i] = __builtin_amdgcn_exp2f(s[blk][i]);
        sum4 += ((f32x4){s[blk][0], s[blk][1], s[blk][2], s[blk][3]} + (f32x4){s[blk][4], s[blk][5], s[blk][6], s[blk][7]}) + ((f32x4){s[blk][8], s[blk][9], s[blk][10], s[blk][11]} + (f32x4){s[blk][12], s[blk][13], s[blk][14], s[blk][15]});
#pragma unroll
        for (int s2 = 0; s2 < 2; ++s2) { pk[2 * blk + s2].x = cvtpk(s[blk][8 * s2], s[blk][8 * s2 + 1]); pk[2 * blk + s2].y = cvtpk(s[blk][8 * s2 + 2], s[blk][8 * s2 + 3]); pk[2 * blk + s2].z = cvtpk(s[blk][8 * s2 + 4], s[blk][8 * s2 + 5]); pk[2 * blk + s2].w = cvtpk(s[blk][8 * s2 + 6], s[blk][8 * s2 + 7]); }
        __builtin_amdgcn_sched_barrier(0);
    }
    sum = (sum4[0] + sum4[1]) + (sum4[2] + sum4[3]);
    sum += __shfl_xor(sum, 32);
    const float inv = 1.0f / (sum + __builtin_amdgcn_exp2f(sink2 - mx));
    if (rv || true) {
        bf16* op = MIX + qrow * DM + 512 + head * 64 + 4 * h;
#pragma unroll
        for (int db = 0; db < 2; ++db) {
            f32x16 o;
#pragma unroll
            for (int i = 0; i < 16; ++i) o[i] = 0.f;
#pragma unroll
            for (int blk = 0; blk < 6; ++blk)
#pragma unroll
                for (int s2 = 0; s2 < 2; ++s2) {
                    const bf16x8 pf = __builtin_bit_cast(bf16x8, pk[2 * blk + s2]);
                    const LAS unsigned char* vp = lds + LDS_VT + (32 * db + r32) * VT_STRIDE + (32 * blk + 16 * s2 + 4 * h) * 2;
                    const s16x4 vlo = *(const LAS s16x4*)vp, vhi = *(const LAS s16x4*)(vp + 16);
                    const bf16x8 vf = {vlo[0], vlo[1], vlo[2], vlo[3], vhi[0], vhi[1], vhi[2], vhi[3]};
                    o = MFMA_BF(vf, pf, o);
                    __builtin_amdgcn_sched_barrier(0);
                }
            if (rv) {
#pragma unroll
                for (int ig = 0; ig < 4; ++ig) { u32x2 w; w.x = cvtpk(o[4 * ig] * inv, o[4 * ig + 1] * inv); w.y = cvtpk(o[4 * ig + 2] * inv, o[4 * ig + 3] * inv); *(u32x2*)(op + 32 * db + 8 * ig) = w; } }
        }
    }
        if (more) {
#pragma unroll
            for (int d0 = 0; d0 < 4; ++d0) qr[d0] = qn[d0]; }
        } else if (more) { attn_fetch(a, l, unit + G, tid, P); attn_qload(a, unit + G, lane, wave, qr); }
        if (more) attn_stage(lds0 + (buf ^ 1) * BUFB, tid, P);
        __syncthreads();
    }
}

__device__ __forceinline__ void state_phase(const Args& a, int l, int tid) {
    const bf16 *U = (const bf16*)(a.ws + WS_U), *Kb = (const bf16*)(a.ws + WS_K), *Vb = (const bf16*)(a.ws + WS_V);
    constexpr int N_PP = 32 * PH * (PW / 8), N_KP = 32 * WIN * (KVW / 8), N_PS = 32 * PH * (PW / 8), N_KS = 32 * DSEQ * (KVW / 8), NTOT = N_PP + 2 * N_KP + N_PS + 2 * N_KS;
    for (int i = blockIdx.x * 512 + tid; i < NTOT; i += gridDim.x * 512) {
        int q = i; const bf16* src; float* dst;
        if (q < N_PP) { const int c8 = q % (PW / 8), t = (q / (PW / 8)) % PH, b = q / (PW / 8 * PH);
            src = U + ((size_t)b * SEQ + (SEQ - PH) + t) * PW + 8 * c8; dst = a.out + O_POOLP + (((size_t)l * 32 + b) * PH + t) * PW + 8 * c8; }
        else if ((q -= N_PP) < 2 * N_KP) { const int kv = q >= N_KP; if (kv) q -= N_KP; const int c8 = q % (KVW / 8), t = (q / (KVW / 8)) % WIN, b = q / (KVW / 8 * WIN);
            src = (kv ? Vb : Kb) + ((size_t)b * SEQ + (SEQ - WIN) + t) * KVW + 8 * c8; dst = a.out + (kv ? O_VP : O_KP) + (((size_t)l * 32 + b) * WIN + t) * KVW + 8 * c8; }
        else if ((q -= 2 * N_KP) < N_PS) { const int c8 = q % (PW / 8), t = (q / (PW / 8)) % PH, b = q / (PW / 8 * PH);
            src = U + ((size_t)MP + b * DSEQ + 1 + t) * PW + 8 * c8; dst = a.out + O_POOLS + (((size_t)l * 32 + b) * PH + t) * PW + 8 * c8; }
        else { q -= N_PS; const int kv = q >= N_KS; if (kv) q -= N_KS; const int c8 = q % (KVW / 8), t = (q / (KVW / 8)) % DSEQ, b = q / (KVW / 8 * DSEQ);
            src = (kv ? Vb : Kb) + ((size_t)MP + b * DSEQ + t) * KVW + 8 * c8; dst = a.out + (kv ? O_VS : O_KS) + (((size_t)l * 32 + b) * WIN + (WIN - DSEQ) + t) * KVW + 8 * c8; }
        float v[8]; ld8(v, src);
        *(f32x4*)dst = (f32x4){v[0], v[1], v[2], v[3]}; *(f32x4*)(dst + 4) = (f32x4){v[4], v[5], v[6], v[7]};
    }
}


template <int KS, class F>
__device__ __forceinline__ void side_gemm(LAS unsigned char* lds, const bf16* A, const bf16* Bt, int K, int ncp, const F& f, int tid, int wave) {
    constexpr int NSUB = 8 / KS;
    const int lane = tid & 63, r = lane & 31, h = lane >> 5, kc = wave & (KS - 1), sub = wave / KS, nitems = (MS / 32) * ncp, Kc = K / KS;
    LAS float* red = (LAS float*)lds + sub * ((KS > 1 ? KS - 1 : 1) * 32 * 64);
    for (int it0 = blockIdx.x * NSUB; it0 < nitems; it0 += gridDim.x * NSUB) {
        const int it = it0 + sub; const bool act = it < nitems; const int rb = it & 15, cp = it >> 4;
        f32x16 c0, c1;
#pragma unroll
        for (int i = 0; i < 16; ++i) { c0[i] = 0.f; c1[i] = 0.f; }
        if (act) {
            const bf16* ap = A + (size_t)(rb * 32 + r) * K + kc * Kc + 8 * h;
            const bf16* b0 = Bt + (size_t)((cp >> 2) * 256 + (cp & 3) * 32 + r) * K + kc * Kc + 8 * h; const bf16* b1 = b0 + (size_t)128 * K;
#pragma unroll (KS == 1 ? 16 : 8)
            for (int k = 0; k < Kc; k += 16) { const bf16x8 af = *(const bf16x8*)(ap + k), w0 = *(const bf16x8*)(b0 + k), w1 = *(const bf16x8*)(b1 + k); c0 = MFMA_BF(w0, af, c0); c1 = MFMA_BF(w1, af, c1); }
            if (KS > 1 && kc != 0) {
#pragma unroll
                for (int i = 0; i < 16; ++i) { red[((kc - 1) * 32 + i) * 64 + lane] = c0[i]; red[((kc - 1) * 32 + 16 + i) * 64 + lane] = c1[i]; } }
        }
        if (KS > 1) __syncthreads();
        if (act && kc == 0) {
            if (KS > 1) {
#pragma unroll (KS > 4 ? 1 : 3)
                for (int p = 0; p < KS - 1; ++p)
#pragma unroll
                    for (int i = 0; i < 16; ++i) { c0[i] += red[(p * 32 + i) * 64 + lane]; c1[i] += red[(p * 32 + 16 + i) * 64 + lane]; } }
            f(MP + rb * 32 + r, h, cp, c0, c1);
        }
        if (KS > 1) __syncthreads();
    }
    if (KS == 1) __syncthreads();
}
#define V4(c, ig) ((f32x4){c[4 * (ig)], c[4 * (ig) + 1], c[4 * (ig) + 2], c[4 * (ig) + 3]})
__device__ __forceinline__ u32x2 pack4(f32x4 v) { u32x2 w; w.x = cvtpk(v[0], v[1]); w.y = cvtpk(v[2], v[3]); return w; }
__device__ __forceinline__ float row_rstd(const float* rss, int row) { const f32x4* p = (const f32x4*)(rss + (size_t)row * 16); const f32x4 a = p[0], b = p[1], c = p[2], d = p[3];
    return rsqrtf((((a[0] + a[1]) + (a[2] + a[3])) + ((b[0] + b[1]) + (b[2] + b[3])) + ((c[0] + c[1]) + (c[2] + c[3])) + ((d[0] + d[1]) + (d[2] + d[3]))) * (1.0f / DM) + EPS); }
struct SIn { const float* rss; const float* bias; bf16 *U, *Q, *K, *V;
    __device__ __forceinline__ void operator()(int row, int h, int cp, const f32x16& c0, const f32x16& c1) const {
        const int pn = cp >> 2, cb = pn * 256 + (cp & 3) * 32 + 4 * h; bf16 *d0, *d1; int pitch; float sc = 1.f;
        if (pn < 2) { d0 = U + cb; d1 = d0 + 128; pitch = PW; } else if (pn < 4) { d0 = Q + (cb - 512); d1 = d0 + 128; pitch = AW; sc = QSCALE; } else { d0 = K + (cb - 1024); d1 = V + (cb - 1024); pitch = KVW; }
        const float rs = row_rstd(rss, row) * sc; const float* bp = bias + (size_t)pg8::row_seq(row) * INW + cb;
#pragma unroll
        for (int ig = 0; ig < 4; ++ig) { *(u32x2*)(d0 + (size_t)row * pitch + 8 * ig) = pack4(V4(c0, ig) * rs + *(const f32x4*)(bp + 8 * ig) * sc); *(u32x2*)(d1 + (size_t)row * pitch + 8 * ig) = pack4(V4(c1, ig) * rs + *(const f32x4*)(bp + 128 + 8 * ig) * sc); }
    } };
struct SRes { bf16* xn; const float* gate; const float* psc; const float* pg; const float* nsc; const float* ng; float* rss;
    __device__ __forceinline__ void operator()(int row, int h, int cp, const f32x16& c0, const f32x16& c1) const {
        const int cb = (cp >> 2) * 256 + (cp & 3) * 32 + 4 * h; const size_t so = (size_t)pg8::row_seq(row) * (6 * DM); float ss = 0.f;
#pragma unroll
        for (int hb = 0; hb < 2; ++hb)
#pragma unroll
            for (int ig = 0; ig < 4; ++ig) { const int c = cb + hb * 128 + 8 * ig; const u32x2 w = *(const u32x2*)(xn + (size_t)row * DM + c);
                const f32x4 x = (f32x4){bf_lo(w.x), bf_hi(w.x), bf_lo(w.y), bf_hi(w.y)} * (1.0f / pg8::gm4(*(const f32x4*)(pg + c), *(const f32x4*)(psc + so + c))) + *(const f32x4*)(gate + so + c) * (hb ? V4(c1, ig) : V4(c0, ig));
                ss += (x[0] * x[0] + x[1] * x[1]) + (x[2] * x[2] + x[3] * x[3]);
                *(u32x2*)(xn + (size_t)row * DM + c) = pack4(nsc ? x * pg8::gm4(*(const f32x4*)(ng + c), *(const f32x4*)(nsc + so + c)) : x); }
        ss += __shfl_xor(ss, 32); if (h == 0) rss[(size_t)row * 16 + cp] = ss;
    } };
struct SGU { const float* rss; const float* bias; bf16* H;
    __device__ __forceinline__ void operator()(int row, int h, int cp, const f32x16& c0, const f32x16& c1) const {
        const int pn = cp >> 2, wc = cp & 3; const float rs = row_rstd(rss, row); const float* bp = bias + (size_t)pg8::row_seq(row) * NGU + pn * 256 + wc * 32 + 4 * h;
#pragma unroll
        for (int ig = 0; ig < 4; ++ig) { const f32x4 a = V4(c0, ig) * rs + *(const f32x4*)(bp + 8 * ig), b = V4(c1, ig) * rs + *(const f32x4*)(bp + 128 + 8 * ig); f32x4 o;
#pragma unroll
            for (int i = 0; i < 4; ++i) o[i] = a[i] * b[i] * __builtin_amdgcn_rcpf(1.0f + __builtin_amdgcn_exp2f(-LOG2E * a[i]));
            *(u32x2*)(H + (size_t)row * DFF + pn * 128 + wc * 32 + 4 * h + 8 * ig) = pack4(o); }
    } };

#define CAS __attribute__((address_space(4)))
__device__ __forceinline__ Args load_args(const CAS Args* p) {
#if defined(__HIP_DEVICE_COMPILE__)
    asm volatile("" : "+s"(p)); Args r; const CAS unsigned long long* q = (const CAS unsigned long long*)p; const float** d = (const float**)&r;
#pragma unroll
    for (int i = 0; i < (int)(sizeof(Args) / 8); ++i) d[i] = (const float*)(const __attribute__((address_space(1))) float*)q[i];
    return r;
#else
    return Args{};
#endif
}
__device__ __forceinline__ int mk_tid(int wave) { unsigned z; asm volatile("s_mov_b32 %0, 0" : "=s"(z)); return wave * 64 + (int)__builtin_amdgcn_mbcnt_hi(~0u, __builtin_amdgcn_mbcnt_lo(~0u, z)); }
__global__ void __launch_bounds__(512, 2) fwd_megakernel(Args a_kernarg) {
    extern __shared__ __attribute__((aligned(16))) unsigned char lds_raw[];
    LAS unsigned char* lds = (LAS unsigned char*)lds_raw;
    cg::grid_group grid = cg::this_grid();
    const CAS Args* ap = (const CAS Args*)__builtin_amdgcn_kernarg_segment_ptr();
    const int wave = __builtin_amdgcn_readfirstlane(threadIdx.x >> 6), G = gridDim.x, bx = blockIdx.x;
    if (threadIdx.x < 64) ((LAS unsigned*)(lds + XB_LDS_OFF))[threadIdx.x] = 0u;
    __syncthreads();
    { const Args a = load_args(ap); (void)xcd_barrier_post((unsigned*)(a.ws + WS_CTL), (volatile LAS unsigned*)(lds + XB_LDS_OFF)); }
#define GRID_BAR() do { const Args a_ = load_args(ap); XcdBarrier b_; b_.bar = (unsigned*)(a_.ws + WS_CTL); b_.x = xb_xcc_id(); b_.st = (volatile LAS unsigned*)(lds + XB_LDS_OFF); xcd_barrier(b_); } while (0)
#ifndef SKIP_P0
#if defined(PROBE_P0X2) || defined(PROBE_P0AX2)
    { const Args a = load_args(ap); const int tid = mk_tid(wave); phase0a(a, lds, tid, tid & 63, wave, 18); }
    GRID_BAR();
#endif
#ifdef PROBE_P0X2
    { const Args a = load_args(ap); const int tid = mk_tid(wave); phase0b(a, lds, tid, tid & 63, wave, 19); }
    GRID_BAR();
#endif
    { const Args a = load_args(ap); const int tid = mk_tid(wave); phase0a(a, lds, tid, tid & 63, wave); }
    grid.sync();
    { const Args a = load_args(ap); const int tid = mk_tid(wave); phase0b(a, lds, tid, tid & 63, wave); }
    GRID_BAR();
#endif
#pragma nounroll
    for (int l = 0; l < DEPTH; ++l) {
#ifndef SKIP_P1
        {
            const Args a = load_args(ap);
            { const int tid = mk_tid(wave); SIn F{(const float*)(a.ws + WS_RSS), (const float*)(a.ws + WS_BIN) + (size_t)l * NSEQ * INW, (bf16*)(a.ws + WS_U), (bf16*)(a.ws + WS_Q), (bf16*)(a.ws + WS_K), (bf16*)(a.ws + WS_V)};
              side_gemm<4>(lds, (const bf16*)(a.ws + WS_XN) + (size_t)MP * DM, (const bf16*)(a.ws + WS_WIN) + (size_t)l * INW * DM, DM, INW / 64, F, tid, wave); }
            pg8::Gemm g{(const bf16*)(a.ws + WS_XN), (const bf16*)(a.ws + WS_WIN) + (size_t)l * INW * DM, MP, INW, DM}; pg8::StaticOrder S; S.init(MP, INW, G, bx);
            pg8::EpiIn E{(const float*)(a.ws + WS_RSS), (const float*)(a.ws + WS_BIN) + (size_t)l * NSEQ * INW, (bf16*)(a.ws + WS_U), (bf16*)(a.ws + WS_Q), (bf16*)(a.ws + WS_K), (bf16*)(a.ws + WS_V)};
            pg8::gemm_phase<pg8::EpiIn, pg8::StaticOrder, true, true>(lds, g, S, E, mk_tid(wave));
#ifdef PROBE_P1X2
            asm volatile("" ::: "memory"); pg8::gemm_phase<pg8::EpiIn, pg8::StaticOrder, true, true>(lds, g, S, E, mk_tid(wave));
#endif
        }
#endif
        GRID_BAR();
#ifndef SKIP_P2
        {
            const Args a = load_args(ap); const int tid = mk_tid(wave), lane = tid & 63;
#ifdef PROBE_P2X2
            for (int rep = 0; rep < 2; ++rep) { asm volatile("" ::: "memory");
#endif
            state_phase(a, l, tid);
            pool_phase(a, l, lane, wave);
            attn_phase(a, lds, l, bx, G, wave);
#ifdef PROBE_P2X2
            }
#endif
        }
#endif
        GRID_BAR();
#ifndef SKIP_P3
        {
            const Args a = load_args(ap);
            bf16* X = (bf16*)(a.ws + WS_XN); const float* modl = (const float*)(a.ws + WS_MOD) + (size_t)l * NSEQ * 6 * DM;
            { const int tid = mk_tid(wave); SRes F{X, modl + 2 * DM, modl + DM, a.g_mix + l * DM, modl + 4 * DM, a.g_ffn + l * DM, (float*)(a.ws + WS_RSS)};
              side_gemm<8>(lds, (const bf16*)(a.ws + WS_MIX) + (size_t)MP * DM, (const bf16*)(a.ws + WS_WO) + (size_t)l * DM * DM, DM, DM / 64, F, tid, wave); }
            pg8::Gemm g{(const bf16*)(a.ws + WS_MIX), (const bf16*)(a.ws + WS_WO) + (size_t)l * DM * DM, MP, DM, DM}; pg8::StaticOrder S; S.init(MP, DM, G, bx, 1);
            pg8::EpiRes E{X, modl + 2 * DM, modl + DM, a.g_mix + l * DM, modl + 4 * DM, a.g_ffn + l * DM, (float*)(a.ws + WS_RSS), (LAS float*)(lds + EPI_LDS_OFF)};
            pg8::gemm_phase<pg8::EpiRes, pg8::StaticOrder, true, true>(lds, g, S, E, mk_tid(wave));
        }
#endif
        GRID_BAR();
#ifndef SKIP_P4
        {
            const Args a = load_args(ap);
            { const int tid = mk_tid(wave); SGU F{(const float*)(a.ws + WS_RSS), (const float*)(a.ws + WS_BGU) + (size_t)l * NSEQ * NGU, (bf16*)(a.ws + WS_H)};
              side_gemm<1>(lds, (const bf16*)(a.ws + WS_XN) + (size_t)MP * DM, (const bf16*)(a.ws + WS_WGU) + (size_t)l * NGU * DM, DM, NGU / 64, F, tid, wave); }
            pg8::Gemm g{(const bf16*)(a.ws + WS_XN), (const bf16*)(a.ws + WS_WGU) + (size_t)l * NGU * DM, MP, NGU, DM}; pg8::StaticOrder S; S.init(MP, NGU, G, bx);
            pg8::EpiGU E{(const float*)(a.ws + WS_RSS), (const float*)(a.ws + WS_BGU) + (size_t)l * NSEQ * NGU, (bf16*)(a.ws + WS_H), (LAS float*)(lds + EGU_LDS_OFF)};
            pg8::gemm_phase<pg8::EpiGU, pg8::StaticOrder, true, true>(lds, g, S, E, mk_tid(wave));
#ifdef PROBE_P4X2
            asm volatile("" ::: "memory"); pg8::gemm_phase<pg8::EpiGU, pg8::StaticOrder, true, true>(lds, g, S, E, mk_tid(wave));
#endif
        }
#endif
        GRID_BAR();
#ifndef SKIP_P5
        {
            const Args a = load_args(ap);
            bf16* X = (bf16*)(a.ws + WS_XN); const float* modl = (const float*)(a.ws + WS_MOD) + (size_t)l * NSEQ * 6 * DM;
            const bool last = l == DEPTH - 1;
            { const int tid = mk_tid(wave); SRes F{X, modl + 5 * DM, modl + 4 * DM, a.g_ffn + l * DM, last ? nullptr : modl + NSEQ * 6 * DM + DM, a.g_mix + (last ? 0 : (l + 1) * DM), (float*)(a.ws + WS_RSS)};
              side_gemm<8>(lds, (const bf16*)(a.ws + WS_H) + (size_t)MP * DFF, (const bf16*)(a.ws + WS_WD) + (size_t)l * DM * DFF, DFF, DM / 64, F, tid, wave); }
            pg8::Gemm g{(const bf16*)(a.ws + WS_H), (const bf16*)(a.ws + WS_WD) + (size_t)l * DM * DFF, MP, DM, DFF}; pg8::StaticOrder S; S.init(MP, DM, G, bx, 1);
            pg8::EpiRes E{X, modl + 5 * DM, modl + 4 * DM, a.g_ffn + l * DM, last ? nullptr : modl + NSEQ * 6 * DM + DM, a.g_mix + (last ? 0 : (l + 1) * DM), (float*)(a.ws + WS_RSS), (LAS float*)(lds + EPI_LDS_OFF)};
            pg8::gemm_phase<pg8::EpiRes, pg8::StaticOrder, true, true>(lds, g, S, E, mk_tid(wave));
        }
#endif
        GRID_BAR();
    }
    {
        const Args a = load_args(ap); const int lane = mk_tid(wave) & 63;
        const bf16* X = (const bf16*)(a.ws + WS_XN); const float* rss = (const float*)(a.ws + WS_RSS);
        f32x4 g0[2], g1[2];
#pragma unroll
        for (int j = 0; j < 2; ++j) { g0[j] = *(const f32x4*)(a.g_final + 8 * (lane + 64 * j)); g1[j] = *(const f32x4*)(a.g_final + 8 * (lane + 64 * j) + 4); }
#pragma unroll 2
        for (int row = bx * 8 + wave; row < MT; row += G * 8) {
            const float pr = lane < 16 ? rss[(size_t)row * 16 + lane] : 0.f;
            const u32x4 w0 = *(const u32x4*)(X + (size_t)row * DM + 8 * lane), w1 = *(const u32x4*)(X + (size_t)row * DM + 8 * (lane + 64));
            const float rstd = rsqrtf(wave_sum(pr) * (1.0f / DM) + EPS);
            float* yr = a.out + (size_t)row * DM; f32x4 lo, hi;
            pg8::unpack8(w0, lo, hi); *(f32x4*)(yr + 8 * lane) = lo * rstd * g0[0]; *(f32x4*)(yr + 8 * lane + 4) = hi * rstd * g1[0];
            pg8::unpack8(w1, lo, hi); *(f32x4*)(yr + 8 * (lane + 64)) = lo * rstd * g0[1]; *(f32x4*)(yr + 8 * (lane + 64) + 4) = hi * rstd * g1[1];
        }
    }
}

extern "C" void kernel_launch(void* const* d_in, const int* in_sizes, int n_in, void* d_out, int out_size, void* d_ws, size_t ws_size, hipStream_t stream) {
    static int grid = 0;
    if (grid == 0) {
        if (n_in != 19 || (size_t)out_size != O_END || ws_size < WS_TOTAL) { fprintf(stderr, "kernel_launch: shape mismatch (n_in %d out %d ws %zu need %zu)\n", n_in, out_size, ws_size, (size_t)WS_TOTAL); grid = -1; return; }
        int dev = 0, cus = 0, per_cu = 0;
        hipGetDevice(&dev); hipDeviceGetAttribute(&cus, hipDeviceAttributeMultiprocessorCount, dev);
        if (hipFuncSetAttribute((const void*)fwd_megakernel, hipFuncAttributeMaxDynamicSharedMemorySize, LDS_BYTES) != hipSuccess) { fprintf(stderr, "kernel_launch: hipFuncSetAttribute failed\n"); grid = -1; return; }
        if (hipOccupancyMaxActiveBlocksPerMultiprocessor(&per_cu, (const void*)fwd_megakernel, 512, LDS_BYTES) != hipSuccess || per_cu < 1) { fprintf(stderr, "kernel_launch: occupancy query says %d\n", per_cu); per_cu = 1; }
        (void)hipGetLastError();
        grid = cus;
    }
    if (grid < 0) return;
    if (hipMemsetAsync((char*)d_ws + WS_CTL, 0, CTL_BYTES, stream) != hipSuccess) { fprintf(stderr, "kernel_launch: memset failed\n"); return; }
    Args a{};
    const float** f = (const float**)&a;
    for (int i = 0; i < 19; ++i) f[i] = (const float*)d_in[i];
    a.out = (float*)d_out; a.ws = (unsigned char*)d_ws;
    void* args[] = {&a};
    hipError_t e = hipLaunchCooperativeKernel((const void*)fwd_megakernel, dim3(grid), dim3(512), args, LDS_BYTES, stream);
    if (e != hipSuccess) fprintf(stderr, "kernel_launch: cooperative launch failed: %s (grid %d)\n", hipGetErrorString(e), grid);
}
```
